# Optimizing an MI355X kernel written in HIP

```python
import math
import jax
import jax.numpy as jnp
from jax import lax
import numpy as np

D_MODEL = 2048
BATCH = 4
SEQ = 4096
DEPTH = 4

D_MIX = D_MODEL
A_WIDTH = D_MIX // 4
A_GROUPS = 4
A_GROUP_DIM = A_WIDTH // A_GROUPS
SGU_CHUNK = 128
R_WIDTH = D_MIX // 4
R_HEADS = 4
R_HEAD_DIM = R_WIDTH // R_HEADS
RET_CHUNK = 128
C_WIDTH = D_MIX // 2
MLA_HEADS = 8
MLA_V_DIM = C_WIDTH // MLA_HEADS
MLA_NOPE = 128
MLA_ROPE = 64
Q_LORA = D_MODEL // 4
KV_LORA = D_MODEL // 8
Q_BLOCK = 128
MEM_LEN = 256
XA_HEADS = 4
XA_HEAD_DIM = D_MODEL // XA_HEADS
D_FF = ((8 * D_MODEL // 3 + 255) // 256) * 256
ROPE_BASE = 10000.0
EPS = 1e-6
IN_SIZES = (A_WIDTH, A_WIDTH,
            R_WIDTH, R_WIDTH, R_WIDTH, R_WIDTH,
            Q_LORA, KV_LORA, MLA_ROPE)
IN_COLS = sum(IN_SIZES)

kernel_name = 'hybrid_gmlp_retention_mla_macaron'


def _split_points():
    pts, acc = [], 0
    for s in IN_SIZES[:-1]:
        acc += s
        pts.append(acc)
    return pts


def rmsnorm(x, g):
    xf = x.astype(jnp.float32)
    y = xf * lax.rsqrt(jnp.mean(xf * xf, axis=-1, keepdims=True) + EPS)
    return (y * g.astype(jnp.float32)).astype(x.dtype)


def swiglu(x, w_gate, w_up, w_down):
    return (jax.nn.silu(x @ w_gate) * (x @ w_up)) @ w_down


def rope(x):
    S, dim = x.shape[1], x.shape[-1]
    half = dim // 2
    pos = jnp.arange(S, dtype=jnp.float32)
    inv_freq = ROPE_BASE ** (-jnp.arange(half, dtype=jnp.float32) * 2.0 / dim)
    ang = pos[:, None] * inv_freq[None, :]
    shape = (1, S) + (1,) * (x.ndim - 3) + (half,)
    cos = jnp.cos(ang).reshape(shape)
    sin = jnp.sin(ang).reshape(shape)
    xf = x.astype(jnp.float32)
    x1, x2 = xf[..., :half], xf[..., half:]
    return jnp.concatenate([x1 * cos - x2 * sin, x2 * cos + x1 * sin], axis=-1).astype(x.dtype)


def sgu_mixer(u, v, norm_g, w_s, b):
    B, S, _ = u.shape
    N = S // SGU_CHUNK
    u = jax.nn.gelu(u)
    v = rmsnorm(jax.nn.gelu(v), norm_g)
    v = v.reshape(B, N, SGU_CHUNK, A_GROUPS, A_GROUP_DIM)
    w = w_s * jnp.tril(jnp.ones((SGU_CHUNK, SGU_CHUNK), w_s.dtype))[None]
    z = jnp.einsum('gts,bnsgc->bntgc', w, v) + b.T[:, :, None]
    return u * z.reshape(B, S, A_WIDTH)


def retention_chunkwise(q, k, v):
    B, S, H, dk = q.shape
    dv = v.shape[-1]
    C = RET_CHUNK
    N = S // C
    log_g = jnp.log1p(-jnp.exp2(-5.0 - jnp.arange(H, dtype=jnp.float32)))
    i = jnp.arange(C, dtype=jnp.float32)
    diff = i[:, None] - i[None, :]
    dmask = jnp.where(diff[None] >= 0,
                      jnp.exp(jnp.maximum(diff, 0.0)[None] * log_g[:, None, None]),
                      0.0).astype(q.dtype)
    zeta = jnp.exp((C - 1 - i)[None, :] * log_g[:, None]).T.astype(q.dtype)
    xi = jnp.exp((i + 1)[None, :] * log_g[:, None]).T.astype(q.dtype)
    g_chunk = jnp.exp(C * log_g).astype(q.dtype)

    q = q.reshape(B, N, C, H, dk)
    k = k.reshape(B, N, C, H, dk) * (dk ** -0.5)
    v = v.reshape(B, N, C, H, dv)

    scores = jnp.einsum('bnihd,bnjhd->bnhij', q, k) * dmask
    inner = jnp.einsum('bnhij,bnjhe->bnihe', scores, v)

    kv = jnp.einsum('bnjhd,bnjhe->nbhde', k * zeta[:, :, None], v)

    def step(state, kv_n):
        return g_chunk[None, :, None, None] * state + kv_n, state

    _, prev = lax.scan(step, jnp.zeros((B, H, dk, dv), kv.dtype), kv)
    cross = jnp.einsum('bnihd,nbhde->bnihe', q * xi[:, :, None], prev)
    return (inner + cross).reshape(B, S, H, dv)


def retention_mixer(q, k, v, g, gn):
    B, S, _ = q.shape
    q = rope(q.reshape(B, S, R_HEADS, R_HEAD_DIM))
    k = rope(k.reshape(B, S, R_HEADS, R_HEAD_DIM))
    v = v.reshape(B, S, R_HEADS, R_HEAD_DIM)
    y = retention_chunkwise(q, k, v).astype(jnp.float32)
    mu = jnp.mean(y, axis=-1, keepdims=True)
    var = jnp.mean(jnp.square(y - mu), axis=-1, keepdims=True)
    y = ((y - mu) * lax.rsqrt(var + EPS)).reshape(B, S, R_WIDTH) * gn.astype(jnp.float32)
    return (jax.nn.silu(g.astype(jnp.float32)) * y).astype(g.dtype)


def causal_mla_attention(q_nope, q_rope, k_nope, k_rope, v):
    B, S, H, _ = q_nope.shape
    nb = S // Q_BLOCK
    scale = (MLA_NOPE + MLA_ROPE) ** -0.5
    qn_b = q_nope.reshape(B, nb, Q_BLOCK, H, -1).transpose(1, 0, 2, 3, 4)
    qr_b = q_rope.reshape(B, nb, Q_BLOCK, H, -1).transpose(1, 0, 2, 3, 4)
    kpos = jnp.arange(S)

    def one_block(args):
        qn, qr, bi = args
        qpos = bi * Q_BLOCK + jnp.arange(Q_BLOCK)
        s = (jnp.einsum('bqhd,bkhd->bhqk', qn, k_nope)
             + jnp.einsum('bqhr,bkr->bhqk', qr, k_rope)).astype(jnp.float32) * scale
        s = jnp.where(kpos[None, :] <= qpos[:, None], s, jnp.float32(-1e30))
        p = jax.nn.softmax(s, axis=-1).astype(v.dtype)
        return jnp.einsum('bhqk,bkhd->bqhd', p, v)

    out = lax.map(one_block, (qn_b, qr_b, jnp.arange(nb)))
    return out.transpose(1, 0, 2, 3, 4).reshape(B, S, H, -1)


def mla_mixer(c_q, c_kv, k_rope, q_norm, w_uq, kv_norm, w_ukv):
    B, S, _ = c_q.shape
    q = (rmsnorm(c_q, q_norm) @ w_uq).reshape(B, S, MLA_HEADS, MLA_NOPE + MLA_ROPE)
    q_nope, q_rope = q[..., :MLA_NOPE], rope(q[..., MLA_NOPE:])
    kv = (rmsnorm(c_kv, kv_norm) @ w_ukv).reshape(B, S, MLA_HEADS, MLA_NOPE + MLA_V_DIM)
    k_nope, v = kv[..., :MLA_NOPE], kv[..., MLA_NOPE:]
    o = causal_mla_attention(q_nope, q_rope, k_nope, rope(k_rope), v)
    return o.reshape(B, S, C_WIDTH)


def memory_cross_attention(n, m, wq, wkv, wo):
    B, S, _ = n.shape
    M = m.shape[1]
    q = (n @ wq).reshape(B, S, XA_HEADS, XA_HEAD_DIM)
    kv = (m @ wkv).reshape(B, M, 2, XA_HEADS, XA_HEAD_DIM)
    s = jnp.einsum('bshd,bmhd->bhsm', q, kv[:, :, 0]).astype(jnp.float32) * (XA_HEAD_DIM ** -0.5)
    p = jax.nn.softmax(s, axis=-1).astype(n.dtype)
    o = jnp.einsum('bhsm,bmhd->bshd', p, kv[:, :, 1]).reshape(B, S, D_MODEL)
    return o @ wo


def setup_inputs(seed: int = 0) -> dict:
    key = jax.random.key(seed)
    ks = jax.random.split(key, 27)
    f32 = jnp.float32
    L = DEPTH

    def w(k, shape, fan_in):
        return jax.random.normal(k, shape, f32) * (fan_in ** -0.5)

    def gain(k, shape):
        return 1.0 + 0.02 * jax.random.normal(k, shape, f32)

    return {
        'x': jax.random.normal(ks[0], (BATCH, SEQ, D_MODEL), f32),
        'mem': jax.random.normal(ks[1], (BATCH, MEM_LEN, D_MODEL), f32),
        'ffn1_norm': gain(ks[2], (L, D_MODEL)),
        'ffn1_w_gate': w(ks[3], (L, D_MODEL, D_FF), D_MODEL),
        'ffn1_w_up': w(ks[4], (L, D_MODEL, D_FF), D_MODEL),
        'ffn1_w_down': w(ks[5], (L, D_FF, D_MODEL), D_FF),
        'mix_norm': gain(ks[6], (L, D_MODEL)),
        'w_in': w(ks[7], (L, D_MODEL, IN_COLS), D_MODEL),
        'sgu_norm': gain(ks[8], (L, A_WIDTH)),
        'sgu_w_s': w(ks[9], (L, A_GROUPS, SGU_CHUNK, SGU_CHUNK), SGU_CHUNK),
        'sgu_b': gain(ks[10], (L, A_GROUPS, SGU_CHUNK)),
        'ret_gn': gain(ks[11], (L, R_WIDTH)),
        'q_norm': gain(ks[12], (L, Q_LORA)),
        'w_uq': w(ks[13], (L, Q_LORA, MLA_HEADS * (MLA_NOPE + MLA_ROPE)), Q_LORA),
        'kv_norm': gain(ks[14], (L, KV_LORA)),
        'w_ukv': w(ks[15], (L, KV_LORA, MLA_HEADS * (MLA_NOPE + MLA_V_DIM)), KV_LORA),
        'w_out': w(ks[16], (L, D_MIX, D_MODEL), D_MIX),
        'xa_norm': gain(ks[17], (L, D_MODEL)),
        'mem_norm': gain(ks[18], (L, D_MODEL)),
        'xa_wq': w(ks[19], (L, D_MODEL, D_MODEL), D_MODEL),
        'xa_wkv': w(ks[20], (L, D_MODEL, 2 * D_MODEL), D_MODEL),
        'xa_wo': w(ks[21], (L, D_MODEL, D_MODEL), D_MODEL),
        'ffn2_norm': gain(ks[22], (L, D_MODEL)),
        'ffn2_w_gate': w(ks[23], (L, D_MODEL, D_FF), D_MODEL),
        'ffn2_w_up': w(ks[24], (L, D_MODEL, D_FF), D_MODEL),
        'ffn2_w_down': w(ks[25], (L, D_FF, D_MODEL), D_FF),
        'final_norm': gain(ks[26], (D_MODEL,)),
    }


def reference(x, mem, ffn1_norm, ffn1_w_gate, ffn1_w_up, ffn1_w_down, mix_norm, w_in,
              sgu_norm, sgu_w_s, sgu_b, ret_gn, q_norm, w_uq, kv_norm, w_ukv, w_out,
              xa_norm, mem_norm, xa_wq, xa_wkv, xa_wo, ffn2_norm, ffn2_w_gate, ffn2_w_up,
              ffn2_w_down, final_norm):
    pts = _split_points()
    h = x
    for l in range(DEPTH):
        h = h + 0.5 * swiglu(rmsnorm(h, ffn1_norm[l]), ffn1_w_gate[l], ffn1_w_up[l], ffn1_w_down[l])
        n = rmsnorm(h, mix_norm[l])
        proj = n @ w_in[l]
        a_u, a_v, r_q, r_k, r_v, r_g, c_q, c_kv, c_kr = jnp.split(proj, pts, axis=-1)
        y_a = sgu_mixer(a_u, a_v, sgu_norm[l], sgu_w_s[l], sgu_b[l])
        y_r = retention_mixer(r_q, r_k, r_v, r_g, ret_gn[l])
        y_c = mla_mixer(c_q, c_kv, c_kr, q_norm[l], w_uq[l], kv_norm[l], w_ukv[l])
        h = h + jnp.concatenate([y_a, y_r, y_c], axis=-1) @ w_out[l]
        h = h + memory_cross_attention(rmsnorm(h, xa_norm[l]), rmsnorm(mem, mem_norm[l]),
                                       xa_wq[l], xa_wkv[l], xa_wo[l])
        h = h + 0.5 * swiglu(rmsnorm(h, ffn2_norm[l]), ffn2_w_gate[l], ffn2_w_up[l], ffn2_w_down[l])
    return rmsnorm(h, final_norm)
```

```cpp
#include <hip/hip_runtime.h>
#include <cstdio>
#include <cstdint>

#define GAS __attribute__((address_space(1)))
#define LAS __attribute__((address_space(3)))
typedef unsigned short bf16_t;
typedef short bf16x8 __attribute__((ext_vector_type(8)));
typedef short s16x4 __attribute__((ext_vector_type(4)));
typedef float f32x2 __attribute__((ext_vector_type(2)));
typedef float f32x4 __attribute__((ext_vector_type(4)));
typedef float f32x16 __attribute__((ext_vector_type(16)));
typedef unsigned u32x2 __attribute__((ext_vector_type(2)));
typedef unsigned u32x4 __attribute__((ext_vector_type(4)));

constexpr int DM = 2048, BATCH = 4, SEQ = 4096, DEPTH = 4, MTOK = BATCH * SEQ;
constexpr int DFF = 5632, NGU = 2 * DFF;
constexpr int INC = 3904, INP = 4096;
constexpr int MEML = 256, MMEM = BATCH * MEML;
constexpr int QW = 1536, KVW = 2048;
constexpr float EPS = 1e-6f;
constexpr float LOG2E = 1.4426950408889634f;

__device__ __forceinline__ unsigned cvt_pk_bf16(float lo, float hi) { unsigned r; asm volatile("v_cvt_pk_bf16_f32 %0, %1, %2" : "=v"(r) : "v"(lo), "v"(hi)); return r; }
typedef __bf16 bf2_t __attribute__((ext_vector_type(2)));
__device__ __forceinline__ unsigned cvt_pk_bf16_c(float lo, float hi) { const f32x2 v = {lo, hi}; return __builtin_bit_cast(unsigned, __builtin_convertvector(v, bf2_t)); }
__device__ __forceinline__ float bf_lo(unsigned w) { return __uint_as_float(w << 16); }
__device__ __forceinline__ float bf_hi(unsigned w) { return __uint_as_float(w & 0xffff0000u); }
__device__ __forceinline__ unsigned ext_q(float h, unsigned hb16) { const int r = (int)(__float_as_uint(h) - hb16) >> 14; return (unsigned)(r > 1 ? 1 : r) & 3u; }
template <int F> __device__ __forceinline__ float ext_join(unsigned hb16, unsigned ew) { return __uint_as_float(hb16 + ((unsigned)__builtin_amdgcn_sbfe((int)ew, 2 * F, 2) << 14) + 0x2000u); }
__device__ __forceinline__ float fast_rcp(float x) { return __builtin_amdgcn_rcpf(x); }
__device__ __forceinline__ float silu_f(float x) { return x * fast_rcp(1.0f + __builtin_amdgcn_exp2f(-x * LOG2E)); }
__device__ __forceinline__ float gelu_f(float x) { const float u = x * (0.7978845608028654f + 0.035677408136300125f * x * x); return x * fast_rcp(1.0f + __builtin_amdgcn_exp2f(-2.0f * LOG2E * u)); }

namespace pg8 {
constexpr int BM = 256, BK = 64, HALF = 128, HTB = HALF * BK * 2  , STAGE_BYTES = 8 * HTB, NXCD = 8, WGM = 8;
__host__ __device__ __forceinline__ int lds_byte(int r, int c) { const int st = (r >> 4) * 2 + (c >> 5), rr = r & 15, cc = c & 31, ob = rr * 64 + cc * 2; return st * 1024 + (ob ^ (((ob >> 9) & 1) << 5)); }
__host__ __device__ __forceinline__ void stage_rc(int b, int& R, int& C) { const int st = b / 1024, sb = b % 1024, swz = sb ^ (((sb >> 9) & 1) << 5); R = (st >> 1) * 16 + swz / 64; C = (st & 1) * 32 + (swz % 64) / 2; }
__host__ __device__ __forceinline__ int perm32(int rho) { const int n = rho >> 4, i = rho & 15; return 8 * (i >> 2) + 4 * n + (i & 3); }

struct Unit { int pm, pn; const char* A; const char* B; size_t coff; };

struct Sched {
    int nM, nN, nwg, G, c;
    const char* A; const char* B; size_t atile, btile, bbatch; int bshift;
    __device__ void init(int M, int N, int G_, int c_, const void* A_, int lda, const void* B_, int ldb) {
        nM = M / BM; nN = N / BM; nwg = nM * nN; G = G_; c = c_; A = (const char*)A_; B = (const char*)B_; atile = (size_t)BM * lda * 2; btile = (size_t)BM * ldb * 2; bbatch = 0; bshift = 30; }
    __device__ bool next(int i, Unit& u) const {
        const long L = (long)i * G + c; if (L >= nwg) return false;
        int wgid = (int)L; { const int q = nwg / NXCD, r = nwg % NXCD, xcd = wgid % NXCD, off = wgid / NXCD; wgid = (xcd < r ? xcd * (q + 1) : r * (q + 1) + (xcd - r) * q) + off; }
        const int nig = WGM * nN, gid = wgid / nig, fm = gid * WGM, gsz = (nM - fm) < WGM ? (nM - fm) : WGM;
        u.pm = fm + ((wgid % nig) % gsz); u.pn = (wgid % nig) / gsz;
        u.A = A + (size_t)u.pm * atile; u.B = B + (size_t)u.pn * btile + (size_t)(u.pm >> bshift) * bbatch; u.coff = 0; return true;
    }
};

template <class Epi, class SchedT, bool ALIGN_EPI = true>
__device__ __forceinline__ void gemm_phase(LAS unsigned char* lds, const int K, const int lda, const int ldb, const SchedT& S, const Epi& E) {
    int tid = threadIdx.x; asm volatile("" : "+v"(tid));
    const int wid = __builtin_amdgcn_readfirstlane(tid >> 6), lane = tid & 63, wr = wid >> 2, wc = wid & 3, fr = lane & 15, fq = lane >> 4;
    int nt = K / BK; asm volatile("" : "+s"(nt));
    unsigned voffA[2], voffB[2];
#pragma unroll
    for (int i = 0; i < 2; ++i) { int R, C; stage_rc(tid * 16 + i * 8192, R, C); const int Rb = Epi::PERM ? ((R & ~31) + perm32(R & 31)) : R;
        voffA[i] = (unsigned)(R * lda + C) * 2u; voffB[i] = (unsigned)(Rb * ldb + C) * 2u; }
    const size_t kstep = (size_t)(BK * 2);
    const size_t hstepA = (size_t)HALF * lda * 2, hstepB = (size_t)HALF * ldb * 2;
    const unsigned ldsw = (unsigned)wid * 1024u;
    const int aoff = lds_byte(wr * 64 + fr, fq * 8), boff = lds_byte(wc * 32 + fr, fq * 8);
#define PG8_SA(b, h) (((b) * 2 + (h)) * HTB)
#define PG8_SB(b, h) ((4 + (b) * 2 + (h)) * HTB)
#define PG8_STAGE(bufoff, gbase, voff) do { _Pragma("unroll") for (int _i = 0; _i < 2; ++_i) \
        __builtin_amdgcn_global_load_lds((const unsigned*)((const char*)(gbase) + (voff)[_i]), (LAS unsigned*)(lds + (bufoff) + ldsw + _i * 8192), 16, 0, 0); } while (0)
#define PG8_LDA(dst, b, h) do { _Pragma("unroll") for (int m = 0; m < 4; ++m) _Pragma("unroll") for (int k = 0; k < 2; ++k) dst[m][k] = *(const LAS bf16x8*)(lds + PG8_SA(b, h) + aoff + m * 2048 + k * 1024); } while (0)
#define PG8_LDB(dst, b, h) do { _Pragma("unroll") for (int n = 0; n < 2; ++n) _Pragma("unroll") for (int k = 0; k < 2; ++k) dst[n][k] = *(const LAS bf16x8*)(lds + PG8_SB(b, h) + boff + n * 2048 + k * 1024); } while (0)
#define PG8_MMA(ai, bj, At, Bt) do { __builtin_amdgcn_s_setprio(1); _Pragma("unroll") for (int m = 0; m < 4; ++m) _Pragma("unroll") for (int n = 0; n < 2; ++n) _Pragma("unroll") for (int k = 0; k < 2; ++k) \
        acc[ai][bj][m][n] = __builtin_amdgcn_mfma_f32_16x16x32_bf16(Bt[n][k], At[m][k], acc[ai][bj][m][n], 0, 0, 0); __builtin_amdgcn_s_setprio(0); } while (0)
#define PG8_WAIT_V(n) asm volatile("s_waitcnt vmcnt(" #n ")" ::: "memory")
#define PG8_WAIT_L(n) asm volatile("s_waitcnt lgkmcnt(" #n ")" ::: "memory")
#define PG8_BAR __builtin_amdgcn_s_barrier()
#define PG8_SCHED __builtin_amdgcn_sched_barrier(0)
    Unit cur, nxt; int ui = 0, pm_prep = -1;
    if (!S.next(0, cur)) return;
    f32x4 acc[2][2][4][2];
#pragma unroll
    for (int a = 0; a < 2; ++a)
#pragma unroll
        for (int b = 0; b < 2; ++b)
#pragma unroll
            for (int m = 0; m < 4; ++m)
#pragma unroll
                for (int n = 0; n < 2; ++n) acc[a][b][m][n] = (f32x4){0.f, 0.f, 0.f, 0.f};
    bf16x8 At[4][2], B0[2][2], B1[2][2];
    const char* cA = cur.A; const char* cB = cur.B;
    PG8_STAGE(PG8_SB(0, 0), cB, voffB); PG8_STAGE(PG8_SB(0, 1), cB + hstepB, voffB); PG8_STAGE(PG8_SA(0, 0), cA, voffA); PG8_STAGE(PG8_SA(0, 1), cA + hstepA, voffA);
    E.prep(cur.pm, wr, lane); pm_prep = cur.pm;
    if (wr == 1) PG8_BAR;
    PG8_WAIT_V(2); PG8_BAR;
    PG8_STAGE(PG8_SB(1, 0), cB + kstep, voffB); PG8_STAGE(PG8_SA(1, 0), cA + kstep, voffA); PG8_STAGE(PG8_SB(1, 1), cB + hstepB + kstep, voffB);
    PG8_WAIT_V(6); PG8_BAR;
    for (;;) {
        const bool has_next = S.next(ui + 1, nxt);
        const char* nA = has_next ? nxt.A : cA; const char* nB = has_next ? nxt.B : cB;
        asm volatile(".p2align 6");
#pragma clang loop unroll(disable)
        for (int t = 0; t < nt; t += 2) {
            const bool last = (t == nt - 2);
            const char* a1 = cA + (size_t)(t + 1) * kstep;
            const char* a2 = last ? nA : cA + (size_t)(t + 2) * kstep; const char* b2 = last ? nB : cB + (size_t)(t + 2) * kstep;
            const char* a3 = a2 + kstep; const char* b3 = b2 + kstep;
            PG8_LDB(B0, 0, 0); PG8_LDB(B1, 0, 1); PG8_SCHED; PG8_LDA(At, 0, 0); PG8_STAGE(PG8_SA(1, 1), a1 + hstepA, voffA);
            PG8_WAIT_V(8); PG8_WAIT_L(0); PG8_BAR; PG8_MMA(0, 0, At, B0); PG8_MMA(0, 1, At, B1); PG8_BAR; PG8_SCHED;
            PG8_LDA(At, 0, 1); PG8_STAGE(PG8_SB(0, 0), b2, voffB); PG8_STAGE(PG8_SB(0, 1), b2 + hstepB, voffB); PG8_STAGE(PG8_SA(0, 0), a2, voffA);
            PG8_WAIT_V(8); PG8_WAIT_L(0); PG8_BAR; PG8_MMA(1, 0, At, B0); PG8_MMA(1, 1, At, B1); PG8_BAR; PG8_SCHED;
            PG8_LDB(B0, 1, 0); PG8_LDB(B1, 1, 1); PG8_SCHED; PG8_LDA(At, 1, 0); PG8_STAGE(PG8_SA(0, 1), a2 + hstepA, voffA);
            PG8_WAIT_V(8); PG8_WAIT_L(0); PG8_BAR; PG8_MMA(0, 0, At, B0); PG8_MMA(0, 1, At, B1); PG8_BAR; PG8_SCHED;
            PG8_LDA(At, 1, 1); PG8_STAGE(PG8_SB(1, 0), b3, voffB); PG8_STAGE(PG8_SB(1, 1), b3 + hstepB, voffB); PG8_STAGE(PG8_SA(1, 0), a3, voffA);
            PG8_WAIT_V(8); PG8_WAIT_L(0); PG8_BAR; PG8_MMA(1, 0, At, B0); PG8_MMA(1, 1, At, B1); PG8_BAR; PG8_SCHED;
        }
        if constexpr (ALIGN_EPI) { if (wr == 0) PG8_BAR; }
        if (cur.pm != pm_prep) { E.prep(cur.pm, wr, lane); pm_prep = cur.pm; }
        E(acc, cur, wr, wc, fr, fq);
        if (!has_next) break;
#pragma unroll
        for (int a = 0; a < 2; ++a)
#pragma unroll
            for (int b = 0; b < 2; ++b)
#pragma unroll
                for (int m = 0; m < 4; ++m)
#pragma unroll
                    for (int n = 0; n < 2; ++n) acc[a][b][m][n] = (f32x4){0.f, 0.f, 0.f, 0.f};
        cur = nxt; cA = nA; cB = nB; ++ui;
        if constexpr (ALIGN_EPI) { if (wr == 1) PG8_BAR; }
    }
    PG8_WAIT_V(0);
    if constexpr (!ALIGN_EPI) { if (wr == 0) PG8_BAR; }
    PG8_BAR;
#undef PG8_SA
#undef PG8_SB
#undef PG8_STAGE
#undef PG8_LDA
#undef PG8_LDB
#undef PG8_MMA
#undef PG8_WAIT_V
#undef PG8_WAIT_L
#undef PG8_BAR
#undef PG8_SCHED
}
}
using pg8::Unit;
#ifndef EPI_NT
#define EPI_NT 0
#endif
#if EPI_NT
#define ST16(p, v) __builtin_nontemporal_store((v), (GAS u32x4*)(p))
#define ST8(p, v) __builtin_nontemporal_store((v), (GAS u32x2*)(p))
#else
#define ST16(p, v) (*(GAS u32x4*)(p) = (v))
#define ST8(p, v) (*(GAS u32x2*)(p) = (v))
#endif
typedef f32x4 (&AccRef)[2][2][4][2];
#define EPI_ROWS  _Pragma("unroll") for (int ai = 0; ai < 2; ++ai) _Pragma("unroll") for (int m = 0; m < 4; ++m)
__device__ __forceinline__ u32x4 pack8(const f32x4 a, const f32x4 b) { u32x4 w; w.x = cvt_pk_bf16(a[0], a[1]); w.y = cvt_pk_bf16(a[2], a[3]); w.z = cvt_pk_bf16(b[0], b[1]); w.w = cvt_pk_bf16(b[2], b[3]); return w; }
__device__ __forceinline__ float dot4(const f32x4 a) { return (a[0] * a[0] + a[1] * a[1]) + (a[2] * a[2] + a[3] * a[3]); }
__device__ __forceinline__ float quad_sum(float s) { s += __shfl_xor(s, 16); s += __shfl_xor(s, 32); return s; }

template <int NP> __device__ __forceinline__ void rstd_prep(const float* ss, int pm, int wr, int lane, float invn, LAS float* rsw) {
#pragma unroll
    for (int i = 0; i < 2; ++i) { const int row = pm * 256 + 128 * i + 64 * wr + lane; const GAS float* p = (const GAS float*)ss + (size_t)row * NP; float s = 0.f;
#pragma unroll
        for (int j = 0; j < NP / 4; ++j) { const f32x4 a = *(const GAS f32x4*)(p + 4 * j); s += (a[0] + a[1]) + (a[2] + a[3]); }
        rsw[64 * i + lane] = __builtin_amdgcn_rsqf(s * invn + EPS); }
    asm volatile("s_waitcnt lgkmcnt(0)" ::: "memory");
}
__device__ __forceinline__ void rstd_fetch(const LAS float* rsw, int fr, float (&rs)[2][4]) { EPI_ROWS rs[ai][m] = rsw[64 * ai + 16 * m + fr]; }

struct EpiGlu {
    static constexpr bool PERM = true;
    LAS float* rsw; __device__ __forceinline__ void prep(int pm, int wr, int lane) const { rstd_prep<32>(ss, pm, wr, lane, 1.0f / DM, rsw); }
    bf16_t* O; const float* ss;
    __device__ __forceinline__ void operator()(AccRef acc, const Unit& u, int wr, int wc, int fr, int fq) const {
        const int rowb = u.pm * 256 + wr * 64 + fr; float rs[2][4]; rstd_fetch(rsw, fr, rs);
        const int col0 = u.pn * 128 + wc * 32 + 8 * fq;
        EPI_ROWS { const float r = rs[ai][m], rl = -r * LOG2E, rr = r * r; f32x4 o[2];
#pragma unroll
            for (int n = 0; n < 2; ++n) { const f32x4 g = acc[ai][0][m][n], u = acc[ai][1][m][n]; const f32x4 a = g * rl; f32x4 e;
#pragma unroll
                for (int k = 0; k < 4; ++k) e[k] = __builtin_amdgcn_exp2f(a[k]);
                const f32x4 den = e + 1.0f; f32x4 rc;
#pragma unroll
                for (int k = 0; k < 4; ++k) rc[k] = fast_rcp(den[k]);
                o[n] = (g * u) * (rc * rr); }
            ST16((O + (size_t)(rowb + 128 * ai + 16 * m) * DFF + col0), pack8(o[0], o[1])); }
    }
};

struct EpiRes {
    static constexpr bool PERM = true;
    __device__ __forceinline__ void prep(int, int, int) const {}
    bf16_t* HB; unsigned* HE; float* ss; float alpha;
    __device__ __forceinline__ void operator()(AccRef acc, const Unit& u, int wr, int wc, int fr, int fq) const {
        const int rowb = u.pm * 256 + wr * 64 + fr, col0 = u.pn * 256 + wc * 32 + 8 * fq;
        GAS unsigned* ep = (GAS unsigned*)HE + ((size_t)((u.pm * 8 + u.pn) * 8 + wr * 4 + wc) * 8) * 64 + fq * 16 + fr;
        EPI_ROWS { const int row = rowb + 128 * ai + 16 * m; float sq = 0.f; const unsigned ew = ep[(ai * 4 + m) * 64]; unsigned eo = 0u;
#pragma unroll
            for (int bj = 0; bj < 2; ++bj) { const size_t o = (size_t)row * DM + col0 + 128 * bj; GAS u32x4* hp = (GAS u32x4*)(HB + o); const u32x4 v = *hp; u32x4 wout;
#define EPR_PAIR(i) { const unsigned w = v[i]; const float x0 = bj ? ext_join<8 + 2 * i>(w << 16, ew) : ext_join<2 * i>(w << 16, ew), x1 = bj ? ext_join<9 + 2 * i>(w & 0xffff0000u, ew) : ext_join<1 + 2 * i>(w & 0xffff0000u, ew); \
                    const unsigned u0 = __float_as_uint(x0 + acc[ai][bj][m][i >> 1][2 * (i & 1)] * alpha) | 1u, u1 = __float_as_uint(x1 + acc[ai][bj][m][i >> 1][2 * (i & 1) + 1] * alpha) | 1u; \
                    const float h0 = __uint_as_float(u0), h1 = __uint_as_float(u1); sq += h0 * h0 + h1 * h1; wout[i] = cvt_pk_bf16(h0, h1); \
                    eo |= __builtin_amdgcn_ubfe(u0, 14, 2) << (2 * (8 * bj + 2 * i)); eo |= __builtin_amdgcn_ubfe(u1, 14, 2) << (2 * (8 * bj + 2 * i + 1)); }
                EPR_PAIR(0) EPR_PAIR(1) EPR_PAIR(2) EPR_PAIR(3)
#undef EPR_PAIR
                *hp = wout; }
            ep[(ai * 4 + m) * 64] = eo;
            sq = quad_sum(sq); if (fq == 0) ((GAS float*)ss)[(size_t)row * 32 + u.pn * 4 + wc] = sq; }
    }
};

struct EpiPlain {
    static constexpr bool PERM = true;
    __device__ __forceinline__ void prep(int, int, int) const {}
    bf16_t* O; int ldc;
    __device__ __forceinline__ void operator()(AccRef acc, const Unit& u, int wr, int wc, int fr, int fq) const {
        const int rowb = u.pm * 256 + wr * 64 + fr, col0 = u.pn * 256 + wc * 32 + 8 * fq;
        EPI_ROWS { bf16_t* rp = O + u.coff + (size_t)(rowb + 128 * ai + 16 * m) * ldc + col0;
#pragma unroll
            for (int bj = 0; bj < 2; ++bj) ST16((rp + 128 * bj), pack8(acc[ai][bj][m][0], acc[ai][bj][m][1])); }
    }
};

struct EpiMix {
    static constexpr bool PERM = true;
    LAS float* rsw; __device__ __forceinline__ void prep(int pm, int wr, int lane) const { rstd_prep<32>(ss, pm, wr, lane, 1.0f / DM, rsw); }
    bf16_t* P; const float* ss; float* ssv; float* ssq; float* ssk; const float* c128; const float* s128; const float* c64; const float* s64;
    __device__ __forceinline__ void operator()(AccRef acc, const Unit& u, int wr, int wc, int fr, int fq) const {
        const int rowb = u.pm * 256 + wr * 64 + fr; float rs[2][4]; rstd_fetch(rsw, fr, rs);
        const int pn = u.pn;
        if (pn >= 4 && pn < 8) {
            const bool isk = pn >= 6; const int head = 2 * (pn & 1) + (wc >> 1), d0 = 32 * (wc & 1) + 8 * fq;
            const float l2g = log2f(1.0f - exp2f(-5.0f - (float)head));
            const int cbase = (isk ? 1536 : 1024) + 128 * head + d0;
            EPI_ROWS { const int row = rowb + 128 * ai + 16 * m, pos = row & (SEQ - 1), pi = pos & 127; const float r = rs[ai][m];
                const float sc = isk ? 0.08838834764831845f * exp2f((float)(127 - pi) * l2g) : exp2f((float)pi * l2g);
                const GAS float* cp = (const GAS float*)c128 + (size_t)pos * 64 + d0; const GAS float* sp = (const GAS float*)s128 + (size_t)pos * 64 + d0;
                f32x4 o1[2], o2[2];
#pragma unroll
                for (int n = 0; n < 2; ++n) { const f32x4 c = *(const GAS f32x4*)(cp + 4 * n), s = *(const GAS f32x4*)(sp + 4 * n); const f32x4 x1 = acc[ai][0][m][n] * r, x2 = acc[ai][1][m][n] * r;
                    o1[n] = (x1 * c - x2 * s) * sc; o2[n] = (x2 * c + x1 * s) * sc; }
                bf16_t* rp = P + (size_t)row * INP + cbase; ST16(rp, pack8(o1[0], o1[1])); ST16((rp + 64), pack8(o2[0], o2[1])); }
        } else if (pn == 15) {
            if (wc == 0) { const int d0 = 8 * fq;
                EPI_ROWS { const int row = rowb + 128 * ai + 16 * m, pos = row & (SEQ - 1); const float r = rs[ai][m];
                    const GAS float* cp = (const GAS float*)c64 + (size_t)pos * 32 + d0; const GAS float* sp = (const GAS float*)s64 + (size_t)pos * 32 + d0;
                    f32x4 o1[2], o2[2];
#pragma unroll
                    for (int n = 0; n < 2; ++n) { const f32x4 c = *(const GAS f32x4*)(cp + 4 * n), s = *(const GAS f32x4*)(sp + 4 * n); const f32x4 x1 = acc[ai][0][m][n] * r, x2 = acc[ai][1][m][n] * r;
                        o1[n] = x1 * c - x2 * s; o2[n] = x2 * c + x1 * s; }
                    bf16_t* rp = P + (size_t)row * INP + 3840 + d0; ST16(rp, pack8(o1[0], o1[1])); ST16((rp + 32), pack8(o2[0], o2[1])); } }
        } else {
            const int act = pn < 4 ? 1 : ((pn == 10 || pn == 11) ? 2 : 0); const int col0 = pn * 256 + wc * 32 + 8 * fq;
            float* sq_out = nullptr; int sq_np = 0, sq_idx = 0;
            if (pn == 2 || pn == 3) { sq_out = ssv; sq_np = 8; sq_idx = (pn - 2) * 4 + wc; } else if (pn == 12 || pn == 13) { sq_out = ssq; sq_np = 8; sq_idx = (pn - 12) * 4 + wc; } else if (pn == 14) { sq_out = ssk; sq_np = 4; sq_idx = wc; }
            EPI_ROWS { const int row = rowb + 128 * ai + 16 * m; const float r = rs[ai][m]; float sq = 0.f;
#pragma unroll
                for (int bj = 0; bj < 2; ++bj) { f32x4 v0 = acc[ai][bj][m][0] * r, v1 = acc[ai][bj][m][1] * r;
                    if (act == 1) {
#pragma unroll
                        for (int e = 0; e < 4; ++e) { v0[e] = gelu_f(v0[e]); v1[e] = gelu_f(v1[e]); } }
                    else if (act == 2) {
#pragma unroll
                        for (int e = 0; e < 4; ++e) { v0[e] = silu_f(v0[e]); v1[e] = silu_f(v1[e]); } }
                    sq += dot4(v0) + dot4(v1);
                    ST16((P + (size_t)row * INP + col0 + 128 * bj), pack8(v0, v1)); }
                if (sq_out) { sq = quad_sum(sq); if (fq == 0) ((GAS float*)sq_out)[(size_t)row * sq_np + sq_idx] = sq; } }
        }
    }
};

struct EpiQ {
    static constexpr bool PERM = true;
    LAS float* rsw; __device__ __forceinline__ void prep(int pm, int wr, int lane) const { rstd_prep<8>(ssq, pm, wr, lane, 1.0f / 512.0f, rsw); }
    bf16_t* Q; const float* ssq; const float* c64; const float* s64;
    __device__ __forceinline__ void operator()(AccRef acc, const Unit& u, int wr, int wc, int fr, int fq) const {
        const int rowb = u.pm * 256 + wr * 64 + fr; float rs[2][4]; rstd_fetch(rsw, fr, rs);
        const float qs = 0.07216878364870322f * LOG2E;
        if (u.pn < 4) {
            EPI_ROWS { const float r = rs[ai][m] * qs; bf16_t* rp = Q + (size_t)(rowb + 128 * ai + 16 * m) * QW + 192 * (2 * u.pn) + wc * 32 + 8 * fq;
#pragma unroll
                for (int bj = 0; bj < 2; ++bj) ST16((rp + 192 * bj), pack8(acc[ai][bj][m][0] * r, acc[ai][bj][m][1] * r)); }
        } else { const int head = 4 * (u.pn - 4) + wc, d0 = 8 * fq;
            EPI_ROWS { const int row = rowb + 128 * ai + 16 * m, pos = row & (SEQ - 1); const float r = rs[ai][m] * qs;
                const GAS float* cp = (const GAS float*)c64 + (size_t)pos * 32 + d0; const GAS float* sp = (const GAS float*)s64 + (size_t)pos * 32 + d0;
                f32x4 o1[2], o2[2];
#pragma unroll
                for (int n = 0; n < 2; ++n) { const f32x4 c = *(const GAS f32x4*)(cp + 4 * n), s = *(const GAS f32x4*)(sp + 4 * n); const f32x4 x1 = acc[ai][0][m][n] * r, x2 = acc[ai][1][m][n] * r;
                    o1[n] = x1 * c - x2 * s; o2[n] = x2 * c + x1 * s; }
                bf16_t* rp = Q + (size_t)row * QW + 192 * head + 128 + d0; ST16(rp, pack8(o1[0], o1[1])); ST16((rp + 32), pack8(o2[0], o2[1])); }
        }
    }
};

struct EpiKV {
    static constexpr bool PERM = true;
    LAS float* rsw; __device__ __forceinline__ void prep(int pm, int wr, int lane) const { rstd_prep<4>(ssk, pm, wr, lane, 1.0f / 256.0f, rsw); }
    bf16_t* KN; const float* ssk;
    __device__ __forceinline__ void operator()(AccRef acc, const Unit& u, int wr, int wc, int fr, int fq) const {
        const int rowb = u.pm * 256 + wr * 64 + fr; float rs[2][4]; rstd_fetch(rsw, fr, rs);
        const int col0 = 128 * u.pn + wc * 32 + 8 * fq;
        EPI_ROWS { const float r = rs[ai][m]; bf16_t* rp = KN + (size_t)(rowb + 128 * ai + 16 * m) * 1024 + col0;
#pragma unroll
            for (int bj = 0; bj < 2; ++bj) ST16((rp + (size_t)bj * ((size_t)MTOK * 1024)), pack8(acc[ai][bj][m][0] * r, acc[ai][bj][m][1] * r)); }
    }
};

struct EpiSm {
    static constexpr bool PERM = true;
    LAS float* rsw; __device__ __forceinline__ void prep(int pm, int wr, int lane) const { rstd_prep<32>(ss, pm, wr, lane, 1.0f / DM, rsw); }
    bf16_t* PX; const float* ss; LAS float* xl;
    __device__ __forceinline__ void operator()(AccRef acc, const Unit& u, int wr, int wc, int fr, int fq) const {
        const int rowb = u.pm * 256 + wr * 64 + fr; float rs[2][4]; rstd_fetch(rsw, fr, rs);
        const float sc = 0.044194173824159216f * LOG2E;
        float mx[2][4];
        EPI_ROWS { float v = -3.0e38f;
#pragma unroll
            for (int bj = 0; bj < 2; ++bj)
#pragma unroll
                for (int n = 0; n < 2; ++n)
#pragma unroll
                    for (int e = 0; e < 4; ++e) v = fmaxf(v, acc[ai][bj][m][n][e]);
            v = fmaxf(v, __shfl_xor(v, 16)); v = fmaxf(v, __shfl_xor(v, 32)); mx[ai][m] = v;
            if (fq == 0) xl[(wr * 64 + 128 * ai + 16 * m + fr) * 4 + wc] = v; }
        asm volatile("s_waitcnt lgkmcnt(0)" ::: "memory"); __builtin_amdgcn_s_barrier(); asm volatile("" ::: "memory");
        EPI_ROWS { const f32x4 t = *(const LAS f32x4*)(xl + (wr * 64 + 128 * ai + 16 * m + fr) * 4); const float r = rs[ai][m] * sc;
            mx[ai][m] = fmaxf(fmaxf(t[0], t[1]), fmaxf(t[2], t[3])) * r; }
        EPI_ROWS { const float r = rs[ai][m] * sc, mr = mx[ai][m]; float s = 0.f;
#pragma unroll
            for (int bj = 0; bj < 2; ++bj)
#pragma unroll
                for (int n = 0; n < 2; ++n) { f32x4 q;
#pragma unroll
                    for (int e = 0; e < 4; ++e) { q[e] = __builtin_amdgcn_exp2f(acc[ai][bj][m][n][e] * r - mr); s += q[e]; }
                    acc[ai][bj][m][n] = q; }
            s = quad_sum(s);
            if (fq == 0) xl[1024 + (wr * 64 + 128 * ai + 16 * m + fr) * 4 + wc] = s; }
        asm volatile("s_waitcnt lgkmcnt(0)" ::: "memory"); __builtin_amdgcn_s_barrier(); asm volatile("" ::: "memory");
        const int col0 = 256 * u.pn + wc * 32 + 8 * fq;
        EPI_ROWS { const f32x4 t = *(const LAS f32x4*)(xl + 1024 + (wr * 64 + 128 * ai + 16 * m + fr) * 4); const float inv = fast_rcp((t[0] + t[1]) + (t[2] + t[3]));
            bf16_t* rp = PX + (size_t)(rowb + 128 * ai + 16 * m) * 1024 + col0;
#pragma unroll
            for (int bj = 0; bj < 2; ++bj) ST16((rp + 128 * bj), pack8(acc[ai][bj][m][0] * inv, acc[ai][bj][m][1] * inv)); }
        asm volatile("s_waitcnt lgkmcnt(0)" ::: "memory"); __builtin_amdgcn_s_barrier(); asm volatile("" ::: "memory");
    }
};
constexpr size_t MiB = 1u << 20;
constexpr size_t WS_CTL = 0, CTL_ZERO_BYTES = 1 * MiB;
constexpr size_t WS_TAB = 1 * MiB;
constexpr size_t TAB_C128 = WS_TAB, TAB_S128 = WS_TAB + 1 * MiB, TAB_C64 = WS_TAB + 2 * MiB, TAB_S64 = WS_TAB + 2 * MiB + 512 * 1024;
constexpr size_t WS_SS = 4 * MiB;
constexpr size_t WS_SSV = 6 * MiB, WS_SSQ = WS_SSV + 512 * 1024, WS_SSK = WS_SSQ + 512 * 1024;
constexpr size_t WS_H = 8 * MiB;
constexpr size_t WS_KVS = WS_H + 32 * MiB, WS_PREV = WS_H + 64 * MiB;
constexpr size_t WS_HB = WS_H + 128 * MiB;
constexpr size_t WS_ACT = WS_HB + 64 * MiB;
constexpr size_t WS_KN = WS_ACT + 176 * MiB, WS_VV = WS_KN + 32 * MiB, WS_YC = WS_VV + 32 * MiB;
constexpr size_t WS_PX = WS_KN;
constexpr size_t WS_LW = WS_YC + 64 * MiB;
constexpr size_t WS_WQG = WS_ACT, WS_WKVT = WS_ACT + 32 * MiB, WS_WOT = WS_ACT + 96 * MiB, WS_KVM = WS_ACT + 128 * MiB, WS_MEMN = WS_ACT + 160 * MiB;
constexpr size_t LW_W1 = 0, LW_W2 = 44 * MiB, LW_W7 = 66 * MiB, LW_W8 = 110 * MiB, LW_WIN = 132 * MiB, LW_WUQ = 148 * MiB, LW_WUKV = LW_WUQ + 3 * MiB / 2, LW_WOUT = LW_WUKV + MiB,
                 LW_BTS = LW_WOUT + 8 * MiB, LW_BTO = LW_BTS + 16 * MiB, LW_WST = LW_BTO + 16 * MiB, LW_STRIDE = LW_WST + MiB;
constexpr size_t WS_PROJ = WS_LW + DEPTH * LW_STRIDE, WS_QM = WS_PROJ + 128 * MiB;
constexpr size_t WS_END = WS_QM + 48 * MiB;
static_assert(WS_VV == WS_KN + (size_t)MTOK * 1024 * 2 && LW_WUKV + MiB == LW_WOUT && (size_t)NGU * DM * 2 == 44 * MiB && (size_t)DM * DFF * 2 == 22 * MiB && (size_t)MTOK * DFF * 2 == 176 * MiB, "ws map");
constexpr int CW_BAR = 4096;
constexpr int CW_QUEUE = 16384;

constexpr int RING_OFF = 0, RING_BYTES = 131072;
constexpr int XL_OFF = RING_BYTES;
constexpr int MISC_OFF = RING_BYTES + 8192;
constexpr int RSW_OFF = MISC_OFF + 256;
constexpr int LDS_BYTES = 147456;

#define RLX_AGENT __ATOMIC_RELAXED, __HIP_MEMORY_SCOPE_AGENT
#define LDS_WAIT() asm volatile("s_waitcnt lgkmcnt(0)" ::: "memory")
#define VM_WAIT() asm volatile("s_waitcnt vmcnt(0)" ::: "memory")

#define XB_TMO      128
#define XB_XCNT(j)  (256  + 64 * (j))
#define XB_XSUB(j)  (1280 + 64 * (j))
#define XB_XGEN(j)  (2304 + 64 * (j))
#define XB_TOP      3328
#define XB_TOPGEN   3392
#define XB_LCNT(j)  (3456 + 64 * (j))
#define XB_TOP2(p)    (7616 + 64 * (p))
#define XB_TOPGEN2(p) (7872 + 64 * (p))
#define XCD_BAR_WORDS 8128
#define XB_SPIN_CAP (1u << 22)

__device__ __forceinline__ unsigned xb_ld(unsigned* p)              { return __hip_atomic_load(p, __ATOMIC_RELAXED, __HIP_MEMORY_SCOPE_AGENT); }
__device__ __forceinline__ unsigned xb_add(unsigned* p, unsigned v) { return __hip_atomic_fetch_add(p, v, __ATOMIC_RELAXED, __HIP_MEMORY_SCOPE_AGENT); }
__device__ __forceinline__ unsigned xb_xcc_id() { return (unsigned)__builtin_amdgcn_s_getreg((3 << 11) | 20) & 0xFu; }
#define XB_SPIN(cond, bar) do { unsigned _sp = 0; while (cond) { __builtin_amdgcn_s_sleep(1); \
    if ((++_sp & 255u) == 0u) { if (xb_ld(&(bar)[XB_TMO])) break; if (_sp > XB_SPIN_CAP) { atomicAdd(&(bar)[XB_TMO], 1u); break; } } } } while (0)

struct XcdBarrier { unsigned* bar; unsigned x; volatile LAS unsigned* st; };

__device__ __forceinline__ XcdBarrier xcd_barrier_post(unsigned* bar, volatile LAS unsigned* st) {
    XcdBarrier b; b.bar = bar; b.x = xb_xcc_id(); b.st = st;
    if (threadIdx.x == 0) st[2] = xb_add(&bar[XB_XCNT(b.x)], 1u);
    return b;
}
__device__ __forceinline__ void xcd_barrier_complete(unsigned* bar, unsigned x, unsigned& nloc, unsigned& nx) {
    const unsigned G = gridDim.x * gridDim.y * gridDim.z;
    unsigned sum, cnt, mine, sp = 0u;
    for (;;) {
        sum = 0u; cnt = 0u; mine = 0u;
#pragma unroll
        for (unsigned j = 0; j < 16; ++j) { const unsigned c = xb_ld(&bar[XB_XCNT(j)]); sum += c; cnt += (c > 0u) ? 1u : 0u; mine = (j == x) ? c : mine; }
        if (sum == G) break;
        __builtin_amdgcn_s_sleep(1);
        if ((++sp & 255u) == 0u) { if (xb_ld(&bar[XB_TMO])) break; if (sp > XB_SPIN_CAP) { atomicAdd(&bar[XB_TMO], 1u); break; } }
    }
    nloc = mine > 0u ? mine : 1u; nx = cnt > 0u ? cnt : 1u;
}
__device__ __forceinline__ void xcd_barrier(const XcdBarrier& b, const int top = XB_TOP, const int topgen = XB_TOPGEN, const unsigned nx_sub = 0u) {
    asm volatile("s_waitcnt vmcnt(0)" ::: "memory");
    __syncthreads();
    if (threadIdx.x == 0) {
        unsigned* bar = b.bar;
        __builtin_amdgcn_s_waitcnt(0);
        unsigned nloc = b.st[0], nx = b.st[1];
        if (nloc == 0u) { xcd_barrier_complete(bar, b.x, nloc, nx); b.st[0] = nloc; b.st[1] = nx; }
        if (nx_sub) nx = nx_sub;
        const unsigned old = xb_add(&bar[XB_XSUB(b.x)], 1u);
        const unsigned gen = old / nloc;
        if (old + 1u == (gen + 1u) * nloc) {
            __builtin_amdgcn_fence(__ATOMIC_RELEASE, "agent");
            asm volatile("s_waitcnt vmcnt(0)" ::: "memory");
            const unsigned og = xb_add(&bar[top], 1u);
            const unsigned tg = og / nx;
            if (og + 1u == (tg + 1u) * nx) xb_add(&bar[topgen], 1u);
            else XB_SPIN(xb_ld(&bar[topgen]) == tg, bar);
            __builtin_amdgcn_fence(__ATOMIC_ACQUIRE, "agent");
            xb_add(&bar[XB_XGEN(b.x)], 1u);
            asm volatile("s_waitcnt vmcnt(0)" ::: "memory");
        } else {
            XB_SPIN(xb_ld(&bar[XB_XGEN(b.x)]) == gen, bar);
            __builtin_amdgcn_fence(__ATOMIC_ACQUIRE, "agent");
            asm volatile("s_waitcnt vmcnt(0)" ::: "memory");
        }
    }
    __syncthreads();
}

#ifndef LOCAL_BAR_RELEASE
#define LOCAL_BAR_RELEASE 0
#endif
__device__ __forceinline__ void xcc_local_barrier(unsigned* bar, unsigned x, unsigned n) {
    asm volatile("s_waitcnt vmcnt(0)" ::: "memory");
    __syncthreads();
    if (threadIdx.x == 0) {
        __builtin_amdgcn_s_waitcnt(0);
        unsigned* cnt = &bar[XB_LCNT(x)];
#if LOCAL_BAR_RELEASE
        __builtin_amdgcn_fence(__ATOMIC_RELEASE, "agent"); asm volatile("s_waitcnt vmcnt(0)" ::: "memory");
#endif
        const unsigned old = xb_add(cnt, 1u), target = (old / n + 1u) * n;
        XB_SPIN(xb_ld(cnt) < target, bar);
        __builtin_amdgcn_fence(__ATOMIC_ACQUIRE, "agent");
        asm volatile("s_waitcnt vmcnt(0)" ::: "memory");
    }
    __syncthreads();
}

struct Frame {
    LAS unsigned char* lds;
    volatile LAS unsigned* MISC;
    unsigned* ctl;
    unsigned char* ws;
    int tid, lane, wave, vcu, G;
};
__device__ __forceinline__ float wave_sum(float v) {
#pragma unroll
    for (int o = 1; o < 64; o <<= 1) v += __shfl_xor(v, o);
    return v;
}
__device__ __forceinline__ unsigned f2bf(float f) { unsigned u = __builtin_bit_cast(unsigned, f); return (u + 0x7fffu + ((u >> 16) & 1u)) >> 16; }
__device__ __forceinline__ unsigned pk2(float lo, float hi) { return f2bf(lo) | (f2bf(hi) << 16); }

__device__ __forceinline__ void xpose_item(const float* W, int Nsrc, int K, bf16_t* WT, const float* gain, int k0, int n0, int sc0, int sc1, LAS unsigned* scr, int lane) {
    const int c4 = lane & 15, rp = lane >> 4; const int scb = (c4 >= 8) ? sc1 : sc0; const bool valid = scb >= 0; const int sc = scb + ((4 * c4) & 31);
    f32x4 ra[8], rb[8];
#pragma unroll
    for (int i = 0; i < 8; ++i) { const int k = k0 + 2 * (4 * i + rp);
        if (valid) { ra[i] = *(const GAS f32x4*)(W + (size_t)k * Nsrc + sc); rb[i] = *(const GAS f32x4*)(W + (size_t)(k + 1) * Nsrc + sc); } else { ra[i] = (f32x4){0.f, 0.f, 0.f, 0.f}; rb[i] = ra[i]; } }
#pragma unroll
    for (int i = 0; i < 8; ++i) { const int kp = 4 * i + rp, k = k0 + 2 * kp; float ga = 1.f, gb = 1.f; if (gain) { ga = ((const GAS float*)gain)[k]; gb = ((const GAS float*)gain)[k + 1]; }
        u32x4 w; w.x = cvt_pk_bf16(ra[i][0] * ga, rb[i][0] * gb); w.y = cvt_pk_bf16(ra[i][1] * ga, rb[i][1] * gb); w.z = cvt_pk_bf16(ra[i][2] * ga, rb[i][2] * gb); w.w = cvt_pk_bf16(ra[i][3] * ga, rb[i][3] * gb);
        *(LAS u32x4*)(scr + ((kp >> 2) + 8 * (kp & 3)) * 68 + 4 * c4) = w; }
    LDS_WAIT(); asm volatile("" ::: "memory");
    const int c = lane & 7;
#pragma unroll
    for (int j = 0; j < 8; ++j) { const int n = 8 * j + (lane >> 3); const LAS unsigned* s = scr + c * 68 + n;
        u32x4 o; o.x = s[0]; o.y = s[8 * 68]; o.z = s[16 * 68]; o.w = s[24 * 68];
        *(GAS u32x4*)(WT + (size_t)(n0 + n) * K + k0 + 8 * c) = o; }
    LDS_WAIT(); asm volatile("" ::: "memory");
}
__device__ __forceinline__ int map_win(int n0) {
    const int t = n0 >> 8, tc = n0 & 255;
    if (t >= 4 && t < 8) { const int s = tc >> 7, j = tc & 127; return (t < 6 ? 1024 : 1536) + 128 * (2 * (t & 1) + (j >> 6)) + 64 * s + (j & 63); }
    if (t == 15) { if (tc == 0) return 3840; if (tc == 128) return 3872; return -1; }
    return n0;
}
__device__ __forceinline__ int map_wuq(int n0) {
    const int t = n0 >> 8, tc = n0 & 255;
    if (t < 4) return 192 * (2 * t + (tc >> 7)) + (tc & 127);
    const int s = tc >> 7, j = tc & 127; return 192 * (4 * (t - 4) + (j >> 5)) + 128 + 32 * s + (j & 31);
}
struct Args { const float* in[27]; float* out; unsigned char* ws; int ph_lo, ph_hi; };
enum { I_X = 0, I_MEM, I_F1N, I_F1G, I_F1U, I_F1D, I_MIXN, I_WIN, I_SGUN, I_SGUW, I_SGUB, I_RETGN, I_QN, I_WUQ, I_KVN, I_WUKV, I_WOUT, I_XAN, I_MEMN, I_XAWQ, I_XAWKV, I_XAWO, I_F2N, I_F2G, I_F2U, I_F2D, I_FIN };

__device__ __forceinline__ bf16_t* lw(unsigned char* ws, int l, size_t off) { return (bf16_t*)(ws + WS_LW + (size_t)l * LW_STRIDE + off); }

__device__ __forceinline__ void p0_prologue(Frame& F, const Args& a) {
    LAS unsigned* scr = (LAS unsigned*)(F.lds + RING_OFF + F.wave * 16384);
    const int gw = F.vcu * 8 + F.wave, NGW = F.G * 8;
    constexpr int I_1 = 32 * 176, I_2 = 88 * 32, I_IN = 32 * 64, I_UQ = 8 * 24, I_UKV = 4 * 32, I_SQ = 32 * 32, I_KV = 32 * 64;
    constexpr int PER_LAYER = 2 * I_1 + 2 * I_2 + I_IN + I_UQ + I_UKV + I_SQ + I_KV + I_SQ;
    for (int it = gw; it < DEPTH * PER_LAYER; it += NGW) {
        const int l = it / PER_LAYER; int r = it % PER_LAYER;
        if (r < 2 * I_1) { const bool f2 = r >= I_1; if (f2) r -= I_1; const int kb = r / 176, nb = r % 176, n0 = nb * 64; const bool up = (n0 >> 7) & 1; const int sc = 128 * (n0 >> 8) + (n0 & 127);
            const float* W = a.in[f2 ? (up ? I_F2U : I_F2G) : (up ? I_F1U : I_F1G)] + (size_t)l * DM * DFF;
            xpose_item(W, DFF, DM, lw(F.ws, l, f2 ? LW_W7 : LW_W1), a.in[f2 ? I_F2N : I_F1N] + l * DM, kb * 64, n0, sc, sc + 32, scr, F.lane); continue; }
        r -= 2 * I_1;
        if (r < 2 * I_2) { const bool f2 = r >= I_2; if (f2) r -= I_2; const int kb = r / 32, nb = r % 32;
            xpose_item(a.in[f2 ? I_F2D : I_F1D] + (size_t)l * DFF * DM, DM, DFF, lw(F.ws, l, f2 ? LW_W8 : LW_W2), nullptr, kb * 64, nb * 64, nb * 64, nb * 64 + 32, scr, F.lane); continue; }
        r -= 2 * I_2;
        if (r < I_IN) { const int kb = r / 64, nb = r % 64;
            xpose_item(a.in[I_WIN] + (size_t)l * DM * INC, INC, DM, lw(F.ws, l, LW_WIN), a.in[I_MIXN] + l * DM, kb * 64, nb * 64, map_win(nb * 64), map_win(nb * 64 + 32), scr, F.lane); continue; }
        r -= I_IN;
        if (r < I_UQ) { const int kb = r / 24, nb = r % 24;
            xpose_item(a.in[I_WUQ] + (size_t)l * 512 * QW, QW, 512, lw(F.ws, l, LW_WUQ), a.in[I_QN] + l * 512, kb * 64, nb * 64, map_wuq(nb * 64), map_wuq(nb * 64 + 32), scr, F.lane); continue; }
        r -= I_UQ;
        if (r < I_UKV) { const int kb = r / 32, nb = r % 32;
            xpose_item(a.in[I_WUKV] + (size_t)l * 256 * KVW, KVW, 256, lw(F.ws, l, LW_WUKV), a.in[I_KVN] + l * 256, kb * 64, nb * 64, nb * 64, nb * 64 + 32, scr, F.lane); continue; }
        r -= I_UKV;
        if (r < I_SQ) { const int kb = r / 32, nb = r % 32;
            xpose_item(a.in[I_WOUT] + (size_t)l * DM * DM, DM, DM, lw(F.ws, l, LW_WOUT), nullptr, kb * 64, nb * 64, nb * 64, nb * 64 + 32, scr, F.lane); continue; }
        r -= I_SQ;
        if (r < I_KV) { const int kb = r / 64, nb = r % 64;
            xpose_item(a.in[I_XAWKV] + (size_t)l * DM * 4096, 4096, DM, (bf16_t*)(F.ws + WS_WKVT) + (size_t)l * 4096 * DM, a.in[I_MEMN] + l * DM, kb * 64, nb * 64, nb * 64, nb * 64 + 32, scr, F.lane); continue; }
        r -= I_KV;
        { const int kb = r / 32, nb = r % 32;
            xpose_item(a.in[I_XAWO] + (size_t)l * DM * DM, DM, DM, (bf16_t*)(F.ws + WS_WOT) + (size_t)l * DM * DM, nullptr, kb * 64, nb * 64, nb * 64, nb * 64 + 32, scr, F.lane); }
    }
    const size_t gt = (size_t)F.vcu * 512 + F.tid, NGT = (size_t)F.G * 512;
    for (size_t i = gt; i < (size_t)DEPTH * DM * DM / 8; i += NGT) { const size_t e = i * 8; const int l = (int)(e / ((size_t)DM * DM)), k = (int)((e / DM) % DM);
        const float g = a.in[I_XAN][l * DM + k]; const GAS f32x4* s = (const GAS f32x4*)(a.in[I_XAWQ] + e); const f32x4 v0 = s[0] * g, v1 = s[1] * g;
        *(GAS u32x4*)((bf16_t*)(F.ws + WS_WQG) + e) = pack8(v0, v1); }
    for (size_t i = gt; i < (size_t)DEPTH * 4 * 128 * 128 / 8; i += NGT) { const size_t e = i * 8; const int l = (int)(e >> 16), t = (int)((e >> 7) & 127), s0 = (int)(e & 127);
        const GAS f32x4* s = (const GAS f32x4*)(a.in[I_SGUW] + e); f32x4 v0 = s[0], v1 = s[1];
#pragma unroll
        for (int j = 0; j < 4; ++j) { if (s0 + j > t) v0[j] = 0.f; if (s0 + 4 + j > t) v1[j] = 0.f; }
        *(GAS u32x4*)(lw(F.ws, l, LW_WST) + (e & 65535)) = pack8(v0, v1); }
    for (size_t i = gt; i < (size_t)SEQ * 96; i += NGT) { const bool big = i < (size_t)SEQ * 64; const size_t j = big ? i : i - (size_t)SEQ * 64; const int half = big ? 64 : 32;
        const int pos = (int)(j / half), d = (int)(j % half); const float inv = exp2f(-(float)d * (2.0f / (float)(2 * half)) * 13.287712379549449f);
        const float ang = (float)pos * inv; double rev = (double)ang * 0.15915494309189535; rev -= floor(rev); const float fr = (float)rev;
        ((float*)(F.ws + (big ? TAB_C128 : TAB_C64)))[j] = __builtin_amdgcn_cosf(fr); ((float*)(F.ws + (big ? TAB_S128 : TAB_S64)))[j] = __builtin_amdgcn_sinf(fr); }
    { const int wr = F.wave >> 2, wc = F.wave & 3, fr = F.lane & 15, fq = F.lane >> 4;
      for (int u = F.vcu; u < 512; u += F.G) { const int pm = u >> 3, pn = u & 7; GAS unsigned* ep = (GAS unsigned*)(F.ws + WS_H) + ((size_t)(u * 8 + F.wave) * 8) * 64 + F.lane;
#pragma unroll 2
        for (int aim = 0; aim < 8; ++aim) { const int row = pm * 256 + wr * 64 + fr + 128 * (aim >> 2) + 16 * (aim & 3); float sq = 0.f; unsigned eo = 0u;
#pragma unroll
            for (int bj = 0; bj < 2; ++bj) { const size_t o = (size_t)row * DM + pn * 256 + wc * 32 + 8 * fq + 128 * bj; const f32x4 v0 = *(const GAS f32x4*)(a.in[I_X] + o), v1 = *(const GAS f32x4*)(a.in[I_X] + o + 4); u32x4 wout;
#pragma unroll
                for (int i = 0; i < 4; ++i) { const float h0 = i < 2 ? v0[2 * (i & 1)] : v1[2 * (i & 1)], h1 = i < 2 ? v0[2 * (i & 1) + 1] : v1[2 * (i & 1) + 1]; const unsigned nw = cvt_pk_bf16(h0, h1); wout[i] = nw;
                    eo |= ext_q(h0, nw << 16) << (2 * (8 * bj + 2 * i)); eo |= ext_q(h1, nw & 0xffff0000u) << (2 * (8 * bj + 2 * i + 1)); sq += h0 * h0 + h1 * h1; }
                *(GAS u32x4*)((bf16_t*)(F.ws + WS_HB) + o) = wout; }
            ep[aim * 64] = eo; sq = quad_sum(sq); if (fq == 0) ((GAS float*)(F.ws + WS_SS))[(size_t)row * 32 + pn * 4 + wc] = sq; } } }
    for (int m = gw; m < MMEM; m += NGW) { const GAS f32x4* xr = (const GAS f32x4*)(a.in[I_MEM] + (size_t)m * DM) + 2 * F.lane; float s = 0.f; f32x4 v[8];
#pragma unroll
        for (int j = 0; j < 4; ++j) { v[2 * j] = xr[128 * j]; v[2 * j + 1] = xr[128 * j + 1]; s += dot4(v[2 * j]) + dot4(v[2 * j + 1]); }
        const float r = 1.0f / sqrtf(wave_sum(s) * (1.0f / DM) + EPS); GAS u32x4* br = (GAS u32x4*)((bf16_t*)(F.ws + WS_MEMN) + (size_t)m * DM) + F.lane;
#pragma unroll
        for (int j = 0; j < 4; ++j) br[64 * j] = pack8(v[2 * j] * r, v[2 * j + 1] * r); }
}

__device__ __forceinline__ void final_norm_phase(Frame& FF, const Args& a, const int panel, const int q, LAS float* rsw) {
    int tid_ = threadIdx.x; asm volatile("" : "+v"(tid_));
    const int lane = tid_ & 63, wave = __builtin_amdgcn_readfirstlane(tid_ >> 6), wr = wave >> 2, wc = wave & 3, fr = lane & 15, fq = lane >> 4;
    const int u0 = panel >= 0 ? panel * 8 + 2 * q : FF.vcu, u1 = panel >= 0 ? u0 + 2 : 512, ustep = panel >= 0 ? 1 : FF.G;
    for (int u = u0; u < u1; u += ustep) { const int pm = u >> 3, pn = u & 7;
        rstd_prep<32>((const float*)(FF.ws + WS_SS), pm, wr, lane, 1.0f / DM, rsw); float rs[2][4]; rstd_fetch(rsw, fr, rs);
        const GAS unsigned* ep = (const GAS unsigned*)(FF.ws + WS_H) + ((size_t)(u * 8 + wave) * 8) * 64 + lane;
        EPI_ROWS { const int row = pm * 256 + wr * 64 + fr + 128 * ai + 16 * m; const float r = rs[ai][m]; const unsigned ew = ep[(ai * 4 + m) * 64];
#pragma unroll
            for (int bj = 0; bj < 2; ++bj) { const int col = pn * 256 + wc * 32 + 8 * fq + 128 * bj; const size_t o = (size_t)row * DM + col; const u32x4 v = *(const GAS u32x4*)((const bf16_t*)(FF.ws + WS_HB) + o);
                const f32x4 g0 = *(const GAS f32x4*)(a.in[I_FIN] + col), g1 = *(const GAS f32x4*)(a.in[I_FIN] + col + 4); f32x4 o0, o1;
#define FN_PAIR(i, dst) { const unsigned w = v[i]; dst[2 * (i & 1)] = bj ? ext_join<8 + 2 * i>(w << 16, ew) : ext_join<2 * i>(w << 16, ew); dst[2 * (i & 1) + 1] = bj ? ext_join<9 + 2 * i>(w & 0xffff0000u, ew) : ext_join<1 + 2 * i>(w & 0xffff0000u, ew); }
                FN_PAIR(0, o0) FN_PAIR(1, o0) FN_PAIR(2, o1) FN_PAIR(3, o1)
#undef FN_PAIR
                *(GAS f32x4*)(a.out + o) = o0 * r * g0; *(GAS f32x4*)(a.out + o + 4) = o1 * r * g1; } }
        asm volatile("s_waitcnt lgkmcnt(0)" ::: "memory"); }
}
#define SBAR() __builtin_amdgcn_sched_barrier(0)
__device__ __forceinline__ int crow(int r, int hi) { return (r & 3) + 8 * (r >> 2) + 4 * hi; }
__device__ __forceinline__ int v_st(int k, int c) { const int kk = (k & ~0xC) | ((k & 4) << 1) | ((k & 8) >> 1); return ((kk >> 3) * 4 + (c >> 5)) * 512 + ((kk & 7) * 32 + (c & 31)) * 2; }
__device__ __forceinline__ int v_rd_base(int lane) { return ((lane & 3) << 3) | (((lane >> 2) & 3) << 6) | (((lane >> 4) & 1) << 5) | (((lane >> 5) & 1) << 8); }
constexpr int v_rd_off(int d0, int ks, int half) { return d0 * 512 + ks * 4096 + half * 2048; }
template <int OFF> __device__ __forceinline__ s16x4 tr_read(int vb) { s16x4 r; asm volatile("ds_read_b64_tr_b16 %0, %1 offset:%2" : "=&v"(r) : "v"(vb), "i"(OFF) : "memory"); return r; }
template <int D0> __device__ __forceinline__ void pv_one(f32x16& od, int vb, bf16x8 pa0, bf16x8 pa1, bf16x8 pa2, bf16x8 pa3) {
    const s16x4 l0 = tr_read<v_rd_off(D0, 0, 0)>(vb), h0 = tr_read<v_rd_off(D0, 0, 1)>(vb), l1 = tr_read<v_rd_off(D0, 1, 0)>(vb), h1 = tr_read<v_rd_off(D0, 1, 1)>(vb);
    const s16x4 l2 = tr_read<v_rd_off(D0, 2, 0)>(vb), h2 = tr_read<v_rd_off(D0, 2, 1)>(vb), l3 = tr_read<v_rd_off(D0, 3, 0)>(vb), h3 = tr_read<v_rd_off(D0, 3, 1)>(vb);
    asm volatile("s_waitcnt lgkmcnt(0)" ::: "memory"); SBAR();
#define PKV(L, H) (bf16x8){L[0], L[1], L[2], L[3], H[0], H[1], H[2], H[3]}
    od = __builtin_amdgcn_mfma_f32_32x32x16_bf16(PKV(l0, h0), pa0, od, 0, 0, 0);
    od = __builtin_amdgcn_mfma_f32_32x32x16_bf16(PKV(l1, h1), pa1, od, 0, 0, 0);
    od = __builtin_amdgcn_mfma_f32_32x32x16_bf16(PKV(l2, h2), pa2, od, 0, 0, 0);
    od = __builtin_amdgcn_mfma_f32_32x32x16_bf16(PKV(l3, h3), pa3, od, 0, 0, 0);
#undef PKV
}
template <int OFF> __device__ __forceinline__ bf16x8 lds_rd128(int addr) { bf16x8 r; asm volatile("ds_read_b128 %0, %1 offset:%2" : "=&v"(r) : "v"(addr), "i"(OFF) : "memory"); return r; }
template <int N> __device__ __forceinline__ void wait_lgkm() { asm volatile("s_waitcnt lgkmcnt(%0)" :: "n"(N) : "memory"); }
template <int D0, int NQ, int KPB> __device__ __forceinline__ void qk_steps(f32x16& p0, f32x16& p1, bf16x8 (&ka)[4], bf16x8 (&kc)[4], const bf16x8 (&qr)[NQ], const int kaddr) {
    if constexpr (D0 < NQ) {
        if constexpr (D0 + 3 < NQ) { ka[(D0 + 3) & 3] = lds_rd128<(D0 + 3) * 32>(kaddr); kc[(D0 + 3) & 3] = lds_rd128<(D0 + 3) * 32 + 32 * KPB>(kaddr); }
        constexpr int later = (D0 + 3 < NQ) ? 3 : NQ - 1 - D0;
        wait_lgkm<2 * later>(); SBAR();
        p0 = __builtin_amdgcn_mfma_f32_32x32x16_bf16(ka[D0 & 3], qr[D0], p0, 0, 0, 0); p1 = __builtin_amdgcn_mfma_f32_32x32x16_bf16(kc[D0 & 3], qr[D0], p1, 0, 0, 0);
        qk_steps<D0 + 1, NQ, KPB>(p0, p1, ka, kc, qr, kaddr);
    }
}
__device__ __forceinline__ float half_comb_sum(float x) { auto rr = __builtin_amdgcn_permlane32_swap(__float_as_uint(x), __float_as_uint(x), false, false); return __uint_as_float(rr[0]) + __uint_as_float(rr[1]); }
__device__ __forceinline__ float half_comb_max(float x) { auto rr = __builtin_amdgcn_permlane32_swap(__float_as_uint(x), __float_as_uint(x), false, false); return fmaxf(__uint_as_float(rr[0]), __uint_as_float(rr[1])); }
__device__ __forceinline__ void p_to_frags(const f32x16& p0, const f32x16& p1, bf16x8& pa0, bf16x8& pa1, bf16x8& pa2, bf16x8& pa3) {
#define PK4(P, BASE, OUT) do { unsigned a0 = cvt_pk_bf16(P[BASE + 0], P[BASE + 1]), a1 = cvt_pk_bf16(P[BASE + 2], P[BASE + 3]);   \
    unsigned b0 = cvt_pk_bf16(P[BASE + 4], P[BASE + 5]), b1 = cvt_pk_bf16(P[BASE + 6], P[BASE + 7]);                              \
    auto r0 = __builtin_amdgcn_permlane32_swap(a0, b0, false, false); auto r1 = __builtin_amdgcn_permlane32_swap(a1, b1, false, false); \
    u32x4 w = {r0[0], r1[0], r0[1], r1[1]}; OUT = __builtin_bit_cast(bf16x8, w); } while (0)
    PK4(p0, 0, pa0); PK4(p0, 8, pa1); PK4(p1, 0, pa2); PK4(p1, 8, pa3);
#undef PK4
}

struct AttnPtrs { const bf16_t* Q; int ldq; const bf16_t* K1; int ldk1; const bf16_t* K2; int ldk2; const bf16_t* V; int ldv; bf16_t* O; int ldo; const bf16_t* SG; int ldsg; const float* gn; float l2g; const bf16_t* PREV; };
template <int MODE>
__device__ __forceinline__ void attn_unit(LAS unsigned char* lds, const int qb, const AttnPtrs& T) {
    constexpr int DQK = MODE == 0 ? 192 : 128, NQ = DQK / 16, KCH = DQK / 8, KPB = DQK * 2 + 16  ,
                  KBYTES = 64 * KPB, NPIECE = KBYTES / 1024, KPT = (NPIECE + 7) / 8;
    static_assert(KBYTES % 1024 == 0, "K image is a whole number of 1 KiB LDS-DMA pieces");
    int tid = threadIdx.x; asm volatile("" : "+v"(tid));
    const int wid = __builtin_amdgcn_readfirstlane(tid >> 6), lane = tid & 63, r32 = lane & 31, hi = lane >> 5;
    constexpr int RING = MODE == 0 ? 3 : 2;
    LAS unsigned char* Kl = lds; LAS unsigned char* Vl = lds + RING * KBYTES;
    const int qmin = qb * 256 + wid * 32, qrow = qmin + r32;
    bf16x8 qr[NQ];
    { const bf16_t* qp = T.Q + (size_t)qrow * T.ldq + 8 * hi;
#pragma unroll
      for (int d0 = 0; d0 < NQ; ++d0) qr[d0] = *(const GAS bf16x8*)(qp + 16 * d0); }
    unsigned ksrc[KPT], vsrc[2];
#pragma unroll
    for (int i = 0; i < KPT; ++i) { const int p = (wid + 8 * i) * 1024 + lane * 16, row = (p / KPB) & 63, chp = (p % KPB) >> 4, ch = chp == KCH ? 0 : chp;
        ksrc[i] = (MODE == 0 && ch >= 16) ? (unsigned)(row * T.ldk2 + 8 * (ch - 16)) | 0x80000000u : (unsigned)(row * T.ldk1 + 8 * ch); }
#pragma unroll
    for (int i = 0; i < 2; ++i) { const int p = (wid * 2 + i) * 1024 + lane * 16, sub = p >> 9, within = (p & 511) >> 1, kk = ((sub >> 2) << 3) | (within >> 5), c = ((sub & 3) << 5) | (within & 31);
        const int k = (kk & ~0xC) | ((kk & 4) << 1) | ((kk & 8) >> 1); vsrc[i] = (unsigned)(k * T.ldv + c); }
    const int vb0 = (int)(unsigned)(uintptr_t)Vl + v_rd_base(lane);
#define A_STAGE(k0, b) do { _Pragma("unroll") for (int i = 0; i < KPT; ++i) if (wid + 8 * i < NPIECE) { \
        const bf16_t* src = (MODE == 0 && (ksrc[i] & 0x80000000u)) ? T.K2 + (size_t)(k0) * T.ldk2 + (ksrc[i] & 0x7fffffffu) : T.K1 + (size_t)(k0) * T.ldk1 + ksrc[i]; \
        __builtin_amdgcn_global_load_lds((const unsigned*)src, (LAS unsigned*)(Kl + (b) * KBYTES + (wid + 8 * i) * 1024), 16, 0, 0); } \
        _Pragma("unroll") for (int i = 0; i < 2; ++i) __builtin_amdgcn_global_load_lds((const unsigned*)(T.V + (size_t)(k0) * T.ldv + vsrc[i]), (LAS unsigned*)(Vl + (b) * 16384 + (wid * 2 + i) * 1024), 16, 0, 0); } while (0)
    f32x16 o[4];
#pragma unroll
    for (int d = 0; d < 4; ++d)
#pragma unroll
        for (int r = 0; r < 16; ++r) o[d][r] = 0.f;
    float m_reg = -1e30f, l_reg = 0.f;
    const int NT = 4 * (qb + 1), KT0 = MODE == 1 ? 4 * qb : 0;
    __syncthreads();
    if constexpr (MODE == 1) {
#pragma unroll
        for (int i = 0; i < 8; ++i) { const int piece = wid * 8 + i, tile = piece >> 4, p = (piece & 15) * 1024 + lane * 16, sub = p >> 9, within = (p & 511) >> 1, kk = ((sub >> 2) << 3) | (within >> 5), c = ((sub & 3) << 5) | (within & 31);
            const int k = (kk & ~0xC) | ((kk & 4) << 1) | ((kk & 8) >> 1);
            __builtin_amdgcn_global_load_lds((const unsigned*)(T.PREV + (size_t)(2 * qb + (tile >> 1)) * 16384 + (size_t)(64 * (tile & 1) + k) * 128 + c), (LAS unsigned*)(lds + 69632 + piece * 1024), 16, 0, 0); } }
    A_STAGE(64 * KT0, 0);
    if (RING == 3 && KT0 + 1 < NT) A_STAGE(64 * KT0 + 64, 1);
    int buf = 0;
    for (int kt = KT0; kt < NT; ++kt) {
        if (RING == 3 && kt + 1 < NT) { if (wid == 0) asm volatile("s_waitcnt vmcnt(6)" ::: "memory"); else asm volatile("s_waitcnt vmcnt(5)" ::: "memory"); }
        else asm volatile("s_waitcnt vmcnt(0)" ::: "memory");
        __syncthreads();
        const int k0 = 64 * kt, bprev = buf == 0 ? RING - 1 : buf - 1;
        if (RING == 3) { if (kt + 2 < NT) A_STAGE(k0 + 128, bprev); } else { if (kt + 1 < NT) A_STAGE(k0 + 64, buf ^ 1); }
        if (k0 <= qmin + 31 && (MODE == 0 || (k0 >> 7) == (qmin >> 7))) {
            f32x16 p0, p1;
#pragma unroll
            for (int r = 0; r < 16; ++r) { p0[r] = 0.f; p1[r] = 0.f; }
            { const int kaddr = (int)(unsigned)(uintptr_t)(Kl + buf * KBYTES + r32 * KPB) + (hi << 4); bf16x8 ka[4], kc[4];
#pragma unroll
              for (int i = 0; i < 3; ++i) { }
              ka[0] = lds_rd128<0>(kaddr); kc[0] = lds_rd128<32 * KPB>(kaddr); ka[1] = lds_rd128<32>(kaddr); kc[1] = lds_rd128<32 + 32 * KPB>(kaddr); ka[2] = lds_rd128<64>(kaddr); kc[2] = lds_rd128<64 + 32 * KPB>(kaddr);
              qk_steps<0, NQ, KPB>(p0, p1, ka, kc, qr, kaddr); }
            const bool diag = k0 + 63 > qmin;
            if constexpr (MODE == 0) {
                if (diag) {
#pragma unroll
                    for (int r = 0; r < 16; ++r) { const int key = k0 + crow(r, hi); if (key > qrow) p0[r] = -1e30f; if (key + 32 > qrow) p1[r] = -1e30f; } }
                float pmax = p0[0];
#pragma unroll
                for (int r = 1; r < 16; ++r) pmax = fmaxf(pmax, p0[r]);
#pragma unroll
                for (int r = 0; r < 16; ++r) pmax = fmaxf(pmax, p1[r]);
                pmax = half_comb_max(pmax);
                const float mn = fmaxf(m_reg, pmax), alpha = __builtin_amdgcn_exp2f(m_reg - mn); m_reg = mn;
                float ps = 0.f;
#pragma unroll
                for (int r = 0; r < 16; ++r) { p0[r] = __builtin_amdgcn_exp2f(p0[r] - mn); p1[r] = __builtin_amdgcn_exp2f(p1[r] - mn); ps += p0[r] + p1[r]; }
                ps = half_comb_sum(ps); l_reg = l_reg * alpha + ps;
                if (__any(alpha < 1.0f)) {
#pragma unroll
                    for (int d = 0; d < 4; ++d)
#pragma unroll
                        for (int r = 0; r < 16; ++r) o[d][r] *= alpha; }
            } else {
                const float cf = exp2f(-127.0f * T.l2g);
#pragma unroll
                for (int r = 0; r < 16; ++r) { p0[r] *= cf; p1[r] *= cf; }
                if (diag) {
#pragma unroll
                    for (int r = 0; r < 16; ++r) { const int key = k0 + crow(r, hi); if (key > qrow) p0[r] = 0.f; if (key + 32 > qrow) p1[r] = 0.f; } }
            }
            bf16x8 pa0, pa1, pa2, pa3; p_to_frags(p0, p1, pa0, pa1, pa2, pa3);
            const int vb = vb0 + buf * 16384;
            pv_one<0>(o[0], vb, pa0, pa1, pa2, pa3); pv_one<1>(o[1], vb, pa0, pa1, pa2, pa3); pv_one<2>(o[2], vb, pa0, pa1, pa2, pa3); pv_one<3>(o[3], vb, pa0, pa1, pa2, pa3);
        }
        buf = buf == RING - 1 ? 0 : buf + 1;
    }
#undef A_STAGE
    if constexpr (MODE == 1) {
        if ((qmin >> 7) > 0) { const int vbp = (int)(unsigned)(uintptr_t)(lds + 69632) + ((wid >> 2) * 32768) + v_rd_base(lane);
            pv_one<0>(o[0], vbp, qr[0], qr[1], qr[2], qr[3]); pv_one<1>(o[1], vbp, qr[0], qr[1], qr[2], qr[3]); pv_one<2>(o[2], vbp, qr[0], qr[1], qr[2], qr[3]); pv_one<3>(o[3], vbp, qr[0], qr[1], qr[2], qr[3]);
            pv_one<0>(o[0], vbp + 16384, qr[4], qr[5], qr[6], qr[7]); pv_one<1>(o[1], vbp + 16384, qr[4], qr[5], qr[6], qr[7]); pv_one<2>(o[2], vbp + 16384, qr[4], qr[5], qr[6], qr[7]); pv_one<3>(o[3], vbp + 16384, qr[4], qr[5], qr[6], qr[7]); } }
    if constexpr (MODE == 0) {
        const float inv = fast_rcp(l_reg); bf16_t* op = T.O + (size_t)qrow * T.ldo + 8 * hi;
#pragma unroll
        for (int d0 = 0; d0 < 4; ++d0)
#pragma unroll
            for (int g = 0; g < 4; g += 2) { const unsigned ax = cvt_pk_bf16_c(o[d0][4 * g] * inv, o[d0][4 * g + 1] * inv), ay = cvt_pk_bf16_c(o[d0][4 * g + 2] * inv, o[d0][4 * g + 3] * inv);
                const unsigned bx = cvt_pk_bf16_c(o[d0][4 * g + 4] * inv, o[d0][4 * g + 5] * inv), by = cvt_pk_bf16_c(o[d0][4 * g + 6] * inv, o[d0][4 * g + 7] * inv);
                const auto rx = __builtin_amdgcn_permlane32_swap(ax, bx, false, false), ry = __builtin_amdgcn_permlane32_swap(ay, by, false, false);
                *(GAS u32x4*)(op + 32 * d0 + 8 * g) = (u32x4){rx[0], ry[0], rx[1], ry[1]}; }
    } else {
        float s = 0.f;
#pragma unroll
        for (int d = 0; d < 4; ++d)
#pragma unroll
            for (int r = 0; r < 16; ++r) s += o[d][r];
        const float mu = half_comb_sum(s) * (1.0f / 128.0f); float q = 0.f;
#pragma unroll
        for (int d = 0; d < 4; ++d)
#pragma unroll
            for (int r = 0; r < 16; ++r) { const float t = o[d][r] - mu; q += t * t; }
        const float rstd = 1.0f / sqrtf(half_comb_sum(q) * (1.0f / 128.0f) + EPS);
        bf16_t* op = T.O + (size_t)qrow * T.ldo + 8 * hi; const bf16_t* gp = T.SG + (size_t)qrow * T.ldsg + 4 * hi; const float* np = T.gn + 4 * hi;
#pragma unroll
        for (int d0 = 0; d0 < 4; ++d0)
#pragma unroll
            for (int g = 0; g < 4; g += 2) { unsigned wx[2], wy[2];
#pragma unroll
                for (int j = 0; j < 2; ++j) { const int gg = g + j; const u32x2 sg = *(const GAS u32x2*)(gp + 32 * d0 + 8 * gg); const f32x4 gv = *(const GAS f32x4*)(np + 32 * d0 + 8 * gg);
                    const float y0 = (o[d0][4 * gg] - mu) * rstd * gv[0] * bf_lo(sg.x), y1 = (o[d0][4 * gg + 1] - mu) * rstd * gv[1] * bf_hi(sg.x);
                    const float y2 = (o[d0][4 * gg + 2] - mu) * rstd * gv[2] * bf_lo(sg.y), y3 = (o[d0][4 * gg + 3] - mu) * rstd * gv[3] * bf_hi(sg.y);
                    wx[j] = cvt_pk_bf16_c(y0, y1); wy[j] = cvt_pk_bf16_c(y2, y3); }
                const auto rx = __builtin_amdgcn_permlane32_swap(wx[0], wx[1], false, false), ry = __builtin_amdgcn_permlane32_swap(wy[0], wy[1], false, false);
                *(GAS u32x4*)(op + 32 * d0 + 8 * g) = (u32x4){rx[0], ry[0], rx[1], ry[1]}; }
    }
}

__device__ __forceinline__ void sgu_unit(LAS unsigned char* lds, const bf16_t* proj  , const float* ssv  , const bf16_t* wst  , const float* gain  ,
                                         const float* bias  , bf16_t* yc  , const int g) {
    int tid = threadIdx.x; asm volatile("" : "+v"(tid));
    const int wid = __builtin_amdgcn_readfirstlane(tid >> 6), lane = tid & 63, r32 = lane & 31, hi = lane >> 5, rb = wid & 3, ch = wid >> 2;
    LAS unsigned char* Vl = lds;
    __syncthreads();
    { const int sr = tid >> 4, sc = (tid & 15) * 8; const f32x4 g0 = *(const GAS f32x4*)(gain + sc), g1 = *(const GAS f32x4*)(gain + sc + 4);
#pragma unroll
      for (int i = 0; i < 4; ++i) { const int s = sr + 32 * i; const GAS f32x4* sp = (const GAS f32x4*)(ssv + (size_t)s * 8); const f32x4 a = sp[0], b2 = sp[1];
          const float rs = __builtin_amdgcn_rsqf((((a[0] + a[1]) + (a[2] + a[3])) + ((b2[0] + b2[1]) + (b2[2] + b2[3]))) * (1.0f / 512.0f) + EPS);
          const u32x4 v = *(const GAS u32x4*)(proj + (size_t)s * INP + 512 + 128 * g + sc);
          f32x4 x0 = {bf_lo(v.x), bf_hi(v.x), bf_lo(v.y), bf_hi(v.y)}, x1 = {bf_lo(v.z), bf_hi(v.z), bf_lo(v.w), bf_hi(v.w)};
          x0 = x0 * g0 * rs; x1 = x1 * g1 * rs;
          *(LAS u32x4*)(Vl + (s >> 6) * 16384 + v_st(s & 63, sc)) = pack8(x0, x1); } }
    bf16x8 pa[8];
    { const bf16_t* wp = wst + (size_t)(32 * rb + r32) * 128 + 8 * hi;
#pragma unroll
      for (int ks = 0; ks < 8; ++ks) pa[ks] = *(const GAS bf16x8*)(wp + 16 * ks); }
    __syncthreads();
    f32x16 o[2];
#pragma unroll
    for (int d = 0; d < 2; ++d)
#pragma unroll
        for (int r = 0; r < 16; ++r) o[d][r] = 0.f;
    const int vb = (int)(unsigned)(uintptr_t)Vl + v_rd_base(lane) + (2 * ch) * 512;
    pv_one<0>(o[0], vb, pa[0], pa[1], pa[2], pa[3]); pv_one<1>(o[1], vb, pa[0], pa[1], pa[2], pa[3]);
    pv_one<0>(o[0], vb + 16384, pa[4], pa[5], pa[6], pa[7]); pv_one<1>(o[1], vb + 16384, pa[4], pa[5], pa[6], pa[7]);
    const int t = 32 * rb + r32; const float bt = bias[t];
    const bf16_t* up = proj + (size_t)t * INP + 128 * g + 64 * ch + 4 * hi; bf16_t* op = yc + (size_t)t * DM + 64 * ch + 4 * hi;
#pragma unroll
    for (int d0 = 0; d0 < 2; ++d0)
#pragma unroll
        for (int q = 0; q < 4; ++q) { const u32x2 uu = *(const GAS u32x2*)(up + 32 * d0 + 8 * q);
            u32x2 w; w.x = cvt_pk_bf16(bf_lo(uu.x) * (o[d0][4 * q] + bt), bf_hi(uu.x) * (o[d0][4 * q + 1] + bt)); w.y = cvt_pk_bf16(bf_lo(uu.y) * (o[d0][4 * q + 2] + bt), bf_hi(uu.y) * (o[d0][4 * q + 3] + bt));
            *(GAS u32x2*)(op + 32 * d0 + 8 * q) = w; }
}

__device__ __forceinline__ void kvstate_unit(LAS unsigned char* lds, const bf16_t* Kp, const bf16_t* Vp  , float* out) {
    int tid = threadIdx.x; asm volatile("" : "+v"(tid));
    const int wid = __builtin_amdgcn_readfirstlane(tid >> 6), lane = tid & 63, r32 = lane & 31, hi = lane >> 5;
    __syncthreads();
#pragma unroll
    for (int i = 0; i < 8; ++i) { const int piece = wid * 8 + i, tile = piece >> 4, p = (piece & 15) * 1024 + lane * 16, sub = p >> 9, within = (p & 511) >> 1, kk = ((sub >> 2) << 3) | (within >> 5), c = ((sub & 3) << 5) | (within & 31);
        const int k = (kk & ~0xC) | ((kk & 4) << 1) | ((kk & 8) >> 1); const bf16_t* src = ((tile & 2) ? Vp : Kp) + (size_t)(64 * (tile & 1) + k) * INP + c;
        __builtin_amdgcn_global_load_lds((const unsigned*)src, (LAS unsigned*)(lds + piece * 1024), 16, 0, 0); }
    asm volatile("s_waitcnt vmcnt(0)" ::: "memory");
    __syncthreads();
    const int D0 = wid & 3, E0 = 2 * (wid >> 2); const int kb = (int)(unsigned)(uintptr_t)lds + v_rd_base(lane) + D0 * 512, vb = (int)(unsigned)(uintptr_t)(lds + 32768) + v_rd_base(lane) + E0 * 512;
    f32x16 a0, a1;
#pragma unroll
    for (int r = 0; r < 16; ++r) { a0[r] = 0.f; a1[r] = 0.f; }
#define PKV(L, H) (bf16x8){L[0], L[1], L[2], L[3], H[0], H[1], H[2], H[3]}
#define KV_STEP(T_, KS) do { const s16x4 kl = tr_read<v_rd_off(0, KS, 0)>(kb + T_ * 16384), kh = tr_read<v_rd_off(0, KS, 1)>(kb + T_ * 16384); \
        const s16x4 ul = tr_read<v_rd_off(0, KS, 0)>(vb + T_ * 16384), uh = tr_read<v_rd_off(0, KS, 1)>(vb + T_ * 16384), wl = tr_read<v_rd_off(1, KS, 0)>(vb + T_ * 16384), wh = tr_read<v_rd_off(1, KS, 1)>(vb + T_ * 16384); \
        asm volatile("s_waitcnt lgkmcnt(0)" ::: "memory"); SBAR(); \
        a0 = __builtin_amdgcn_mfma_f32_32x32x16_bf16(PKV(kl, kh), PKV(ul, uh), a0, 0, 0, 0); a1 = __builtin_amdgcn_mfma_f32_32x32x16_bf16(PKV(kl, kh), PKV(wl, wh), a1, 0, 0, 0); } while (0)
    KV_STEP(0, 0); KV_STEP(0, 1); KV_STEP(0, 2); KV_STEP(0, 3); KV_STEP(1, 0); KV_STEP(1, 1); KV_STEP(1, 2); KV_STEP(1, 3);
#undef KV_STEP
#undef PKV
    GAS float* op = (GAS float*)out + (size_t)(32 * D0 + 4 * hi) * 128 + 32 * E0 + r32;
#pragma unroll
    for (int r = 0; r < 16; ++r) { const int ro = ((r & 3) + 8 * (r >> 2)) * 128; op[ro] = a0[r]; op[ro + 32] = a1[r]; }
}
__device__ __forceinline__ void retention_scan(const float* kvs, bf16_t* prev, int gtid  ) {
    const int bh = gtid >> 13, de = (gtid & 8191) * 2, h = bh & 3; const float l2g = log2f(1.0f - exp2f(-5.0f - (float)h)), gam = exp2f(l2g), g128 = exp2f(128.0f * l2g);
    const GAS f32x2* s = (const GAS f32x2*)(kvs + (size_t)bh * 32 * 16384 + de); GAS unsigned* p = (GAS unsigned*)(prev + (size_t)bh * 32 * 16384 + de);
    float s0 = 0.f, s1 = 0.f;
#pragma unroll 8
    for (int n = 0; n < 32; ++n) { p[(size_t)n * 8192] = cvt_pk_bf16(gam * s0, gam * s1); const f32x2 v = s[(size_t)n * 8192]; s0 = g128 * s0 + v[0]; s1 = g128 * s1 + v[1]; }
}
struct SchedKvm : pg8::Sched {
    __device__ bool next(int i, Unit& u) const { if (!pg8::Sched::next(i, u)) return false; u.coff = (size_t)(u.pn >> 4) * ((size_t)MMEM * 4096 - 4096); return true; }
};
struct SchedAT {
    int G, c; unsigned char* ws;
    __device__ bool next(int i, Unit& u) const { const int L = i * G + c; if (L >= 512) return false; const int lbh = L >> 3, pn = L & 7, l = lbh >> 4, b = (lbh >> 2) & 3, h = lbh & 3;
        u.pm = 0; u.pn = pn;
        u.A = (const char*)(ws + WS_KVM) + ((size_t)l * MMEM * 4096 + (size_t)(b * 256) * 4096 + 512 * h) * 2;
        u.B = (const char*)(ws + WS_WQG) + ((size_t)l * DM * DM + (size_t)(256 * pn) * DM + 512 * h) * 2;
        u.coff = (size_t)l * (LW_STRIDE / 2) + (size_t)b * 1024 * DM + (size_t)(256 * h) * DM; return true; }
};
struct SchedCT {
    int G, c; unsigned char* ws;
    __device__ bool next(int i, Unit& u) const { const int L = i * G + c; if (L >= 512) return false; const int lbh = L >> 3, pm = L & 7, l = lbh >> 4, b = (lbh >> 2) & 3, h = lbh & 3;
        u.pm = pm; u.pn = 0;
        u.A = (const char*)(ws + WS_WOT) + ((size_t)l * DM * DM + (size_t)(256 * pm) * DM + 512 * h) * 2;
        u.B = (const char*)(ws + WS_KVM) + ((size_t)l * MMEM * 4096 + (size_t)(b * 256) * 4096 + 2048 + 512 * h) * 2;
        u.coff = (size_t)l * (LW_STRIDE / 2) + (size_t)b * DM * 1024 + 256 * h; return true; }
};

constexpr int NPRO = 3, NLP = 10, PH_FINAL = NPRO + DEPTH * NLP, NPHASE = PH_FINAL + 1;
__global__ void __launch_bounds__(512, 2) fwd_kernel(Args args) {
    extern __shared__ __attribute__((aligned(16))) unsigned char lds_raw[];
    Frame F;
    F.lds = (LAS unsigned char*)lds_raw;
    F.MISC = (volatile LAS unsigned*)(F.lds + MISC_OFF);
    F.tid = threadIdx.x; F.lane = F.tid & 63; F.wave = __builtin_amdgcn_readfirstlane(F.tid >> 6);
    F.G = gridDim.x; { const int bx = blockIdx.x; F.vcu = (F.G % 8 == 0) ? (bx % 8) * (F.G / 8) + bx / 8 : bx; }
    F.ws = args.ws; F.ctl = (unsigned*)(args.ws + WS_CTL);
    unsigned char* ws = args.ws;
    if (F.tid < 32) F.MISC[F.tid] = 0u;
    __syncthreads();
    const int lo = args.ph_lo, hi = args.ph_hi;
    XcdBarrier bar; bar.bar = F.ctl + CW_BAR; bar.x = 0; bar.st = nullptr;
    if (hi - lo > 1) bar = xcd_barrier_post(F.ctl + CW_BAR, F.MISC + 8);
#ifndef PH_MASK
#define PH_MASK 0xFFFF
#endif
#define PHON(id) (((PH_MASK) >> (id)) & 1)
#ifndef REP_MASK
#define REP_MASK 0
#endif
#define NREP(id) (1 + (((REP_MASK) >> (id)) & 1))
#define IN(k) (lo <= (k) && (k) < hi)
#define SEAM(k) do { if (IN(k) && IN((k) + 1)) xcd_barrier(bar); } while (0)
    const int cid = (int)blockIdx.x;
    LAS float* const RSW = (LAS float*)(F.lds + RSW_OFF) + F.wave * 128;
    if (PHON(10) && IN(0)) { for (int rep = 0; rep < NREP(10); ++rep) p0_prologue(F, args); } SEAM(0);
    if (PHON(11) && IN(1)) for (int rep = 0; rep < NREP(11); ++rep) { SchedKvm S; S.init(MMEM, DEPTH * 4096, F.G, cid, ws + WS_MEMN, DM, ws + WS_WKVT, DM);
        EpiPlain E{(bf16_t*)(ws + WS_KVM), 4096}; pg8::gemm_phase<EpiPlain, SchedKvm>(F.lds + RING_OFF, DM, DM, DM, S, E); } SEAM(1);
    if (PHON(12) && IN(2)) for (int rep = 0; rep < NREP(12); ++rep) { { SchedAT S{F.G, cid, ws}; EpiPlain E{(bf16_t*)(ws + WS_LW + LW_BTS), DM}; pg8::gemm_phase<EpiPlain, SchedAT>(F.lds + RING_OFF, 512, 4096, DM, S, E); }
                 { SchedCT S{F.G, cid, ws}; EpiPlain E{(bf16_t*)(ws + WS_LW + LW_BTO), 1024}; pg8::gemm_phase<EpiPlain, SchedCT>(F.lds + RING_OFF, 512, DM, 4096, S, E); } } SEAM(2);

    bool local_ok = false; int cidl = (int)blockIdx.x;
    if (hi - lo == NPHASE) {
        if (F.tid == 0) { bool ok = F.G == 256; for (unsigned j = 0; j < 16; ++j) { const unsigned c = xb_ld(&bar.bar[XB_XCNT(j)]); ok = ok && (j < 8 ? c == 32u : c == 0u); } F.MISC[11] = ok ? 1u : 0u; }
        __syncthreads();
        local_ok = __builtin_amdgcn_readfirstlane((int)F.MISC[11]) != 0; if (local_ok) cidl = __builtin_amdgcn_readfirstlane((int)F.MISC[10] * 8 + (int)bar.x);
    }
#ifndef LOCAL_BAR_ON
#define LOCAL_BAR_ON 1
#endif
#define SEAM_L(k) do { if (IN(k) && IN((k) + 1)) { if (local_ok && LOCAL_BAR_ON) xcc_local_barrier(bar.bar, 8u * bar.x + (unsigned)((cidl >> 3) & 7), 4u); else xcd_barrier(bar); } } while (0)
#define SEAM_P(k) do { if (IN(k) && IN((k) + 1)) { if (local_ok && LOCAL_BAR_ON) xcd_barrier(bar, XB_TOP2(bar.x >> 1), XB_TOPGEN2(bar.x >> 1), 2u); else xcd_barrier(bar); } } while (0)
#pragma clang loop unroll(disable)
    for (int l = 0; l < DEPTH; ++l) {
        const int pb = NPRO + NLP * l; int cid = cidl;
        asm volatile("" : "+s"(ws));
        asm volatile("" : "+s"(cid));
        unsigned* const HLp = (unsigned*)(ws + WS_H); bf16_t* const HBp = (bf16_t*)(ws + WS_HB); float* const SSp = (float*)(ws + WS_SS);
        bf16_t* const ACTp = (bf16_t*)(ws + WS_ACT); bf16_t* const PROJp = (bf16_t*)(ws + WS_PROJ); bf16_t* const QMp = (bf16_t*)(ws + WS_QM);
        bf16_t* const KNp = (bf16_t*)(ws + WS_KN); bf16_t* const VVp = (bf16_t*)(ws + WS_VV); bf16_t* const YCp = (bf16_t*)(ws + WS_YC); bf16_t* const PXp = (bf16_t*)(ws + WS_PX);
        float* const SSVp = (float*)(ws + WS_SSV); float* const SSQp = (float*)(ws + WS_SSQ); float* const SSKp = (float*)(ws + WS_SSK);
        const float* const C128 = (const float*)(ws + TAB_C128); const float* const S128 = (const float*)(ws + TAB_S128); const float* const C64 = (const float*)(ws + TAB_C64); const float* const S64 = (const float*)(ws + TAB_S64);

        if (PHON(0) && IN(pb + 0)) for (int rep = 0; rep < NREP(0); ++rep) { pg8::Sched S; S.init(MTOK, NGU, F.G, cid, HBp, DM, lw(ws, l, LW_W1), DM); EpiGlu E{RSW, ACTp, SSp}; pg8::gemm_phase<EpiGlu, pg8::Sched>(F.lds + RING_OFF, DM, DM, DM, S, E); } SEAM_L(pb + 0);
        if (PHON(1) && IN(pb + 1)) for (int rep = 0; rep < NREP(1); ++rep) { pg8::Sched S; S.init(MTOK, DM, F.G, cid, ACTp, DFF, lw(ws, l, LW_W2), DFF); EpiRes E{HBp, HLp, SSp, rep ? 0.0f : 0.5f}; pg8::gemm_phase<EpiRes, pg8::Sched>(F.lds + RING_OFF, DFF, DFF, DFF, S, E); } SEAM_L(pb + 1);
        if (PHON(2) && IN(pb + 2)) for (int rep = 0; rep < NREP(2); ++rep) { pg8::Sched S; S.init(MTOK, INP, F.G, cid, HBp, DM, lw(ws, l, LW_WIN), DM); EpiMix E{RSW, PROJp, SSp, SSVp, SSQp, SSKp, C128, S128, C64, S64};
            pg8::gemm_phase<EpiMix, pg8::Sched>(F.lds + RING_OFF, DM, DM, DM, S, E); } SEAM_L(pb + 2);
        if (IN(pb + 3)) for (int rep = 0; rep < NREP(3); ++rep) {
            if (PHON(3)) { pg8::Sched S; S.init(MTOK, QW, F.G, cid, PROJp + 3072, INP, lw(ws, l, LW_WUQ), 512); EpiQ E{RSW, QMp, SSQp, C64, S64}; pg8::gemm_phase<EpiQ, pg8::Sched>(F.lds + RING_OFF, 512, INP, 512, S, E); }
            if (PHON(8)) { pg8::Sched S; S.init(MTOK, KVW, F.G, cid, PROJp + 3584, INP, lw(ws, l, LW_WUKV), 256); EpiKV E{RSW, KNp, SSKp}; pg8::gemm_phase<EpiKV, pg8::Sched>(F.lds + RING_OFF, 256, INP, 256, S, E); }
            for (int w = (F.G == 256 ? 0 : cid); w < (F.G == 256 ? 1 : 512); w += F.G) {
            const int q = (cid >> 3) >> 3, u0 = F.G == 256 ? (q < 2 ? q : 3 * q - 4) : (w & 7), u1 = F.G == 256 ? (q < 2 ? q + 1 : 3 * q - 1) : (w & 7) + 1, pan = F.G == 256 ? 8 * (cid & 7) + ((cid >> 3) & 7) : (w >> 3);
            if (PHON(9)) for (int u = u0; u < u1; ++u) { const int g = u & 3, bn = 2 * pan + (u >> 2); const size_t t0 = (size_t)bn * 128;
                sgu_unit(F.lds + RING_OFF, PROJp + t0 * INP, SSVp + t0 * 8, lw(ws, l, LW_WST) + g * 16384, args.in[I_SGUN] + l * 512 + 128 * g, args.in[I_SGUB] + l * 512 + 128 * g, YCp + t0 * DM + 128 * g, g); }
            if (PHON(9)) for (int u = u0; u < u1; ++u) { const int h = u & 3, bn = 2 * pan + (u >> 2), b = bn >> 5, n = bn & 31; const bf16_t* pr = PROJp + (size_t)bn * 128 * INP + 128 * h;
                kvstate_unit(F.lds + RING_OFF, pr + 1536, pr + 2048, (float*)(ws + WS_KVS) + (size_t)((b * 4 + h) * 32 + n) * 16384); } }
        } SEAM_P(pb + 3);
        if (PHON(4) && IN(pb + 4)) for (int rep = 0; rep < NREP(4); ++rep) {
            const bool pairq = local_ok && LOCAL_BAR_ON; const int bq0 = pairq ? (cid & 7) >> 1 : (int)(((long)cid * 4) / F.G);
            for (int kq = 0; kq < (pairq ? 1 : 4); ++kq) { const int bq = (bq0 + kq) & 3;
            unsigned* head = F.ctl + CW_QUEUE + 64 * ((l + 4 * rep) * 4 + bq);
            for (;;) {
                __syncthreads();
                if (F.tid == 0) F.MISC[0] = __hip_atomic_fetch_add(head, 1u, RLX_AGENT);
                __syncthreads();
                const int qi = (int)F.MISC[0];
                if (qi >= 16 + 192) break;
                unsigned* sflag = F.ctl + CW_QUEUE + 64 * (32 + l * 4 + bq);
                if (qi < 16) {
                    int t_ = threadIdx.x; asm volatile("" : "+v"(t_));
                    for (int q = 0; q < 4; ++q) retention_scan((const float*)(ws + WS_KVS), (bf16_t*)(ws + WS_PREV), (16 * bq + qi) * 2048 + q * 512 + t_);
                    asm volatile("s_waitcnt vmcnt(0)" ::: "memory"); __syncthreads();
                    if (F.tid == 0) { __builtin_amdgcn_fence(__ATOMIC_RELEASE, "agent"); asm volatile("s_waitcnt vmcnt(0)" ::: "memory"); (void)__hip_atomic_fetch_add(sflag, 1u, RLX_AGENT); }
                    continue; }
                const int idx = qi - 16, b = bq;
                if (idx < 128) { const int qb = 15 - (idx >> 3), h = idx & 7; const size_t row0 = (size_t)b * SEQ;
                    AttnPtrs T{QMp + row0 * QW + 192 * h, QW, KNp + row0 * 1024 + 128 * h, 1024, PROJp + row0 * INP + 3840, INP, VVp + row0 * 1024 + 128 * h, 1024, YCp + row0 * DM + 1024 + 128 * h, DM, nullptr, 0, nullptr, 0.f, nullptr};
                    attn_unit<0>(F.lds + RING_OFF, qb, T);
                } else { const int j = idx - 128, qb = j >> 2, h = j & 3; const size_t row0 = (size_t)b * SEQ; const bf16_t* pr = PROJp + row0 * INP + 128 * h;
                    if (F.tid == 0) { unsigned sp = 0; while (__hip_atomic_load(sflag, RLX_AGENT) < 16u) { __builtin_amdgcn_s_sleep(2); if (++sp > (1u << 22)) break; }
                        __builtin_amdgcn_fence(__ATOMIC_ACQUIRE, "agent"); asm volatile("s_waitcnt vmcnt(0)" ::: "memory"); }
                    __syncthreads();
                    AttnPtrs T{pr + 1024, INP, pr + 1536, INP, nullptr, 0, pr + 2048, INP, YCp + row0 * DM + 512 + 128 * h, DM, pr + 2560, INP, args.in[I_RETGN] + l * 512 + 128 * h, log2f(1.0f - exp2f(-5.0f - (float)h)), (const bf16_t*)(ws + WS_PREV) + (size_t)(b * 4 + h) * 32 * 16384};
                    attn_unit<1>(F.lds + RING_OFF, qb, T); }
            } }
        } SEAM_P(pb + 4);
        if (PHON(5) && IN(pb + 5)) for (int rep = 0; rep < NREP(5); ++rep) { pg8::Sched S; S.init(MTOK, DM, F.G, cid, YCp, DM, lw(ws, l, LW_WOUT), DM); EpiRes E{HBp, HLp, SSp, rep ? 0.0f : 1.0f}; pg8::gemm_phase<EpiRes, pg8::Sched>(F.lds + RING_OFF, DM, DM, DM, S, E); } SEAM_L(pb + 5);
        if (PHON(6) && IN(pb + 6)) for (int rep = 0; rep < NREP(6); ++rep) { pg8::Sched S; S.init(MTOK, 1024, F.G, cid, HBp, DM, lw(ws, l, LW_BTS), DM); S.bshift = 4; S.bbatch = (size_t)1024 * DM * 2; EpiSm E{RSW, PXp, SSp, (LAS float*)(F.lds + XL_OFF)};
            pg8::gemm_phase<EpiSm, pg8::Sched>(F.lds + RING_OFF, DM, DM, DM, S, E); } SEAM_L(pb + 6);
        if (PHON(7) && IN(pb + 7)) for (int rep = 0; rep < NREP(7); ++rep) { pg8::Sched S; S.init(MTOK, DM, F.G, cid, PXp, 1024, lw(ws, l, LW_BTO), 1024); S.bshift = 4; S.bbatch = (size_t)DM * 1024 * 2; EpiRes E{HBp, HLp, SSp, rep ? 0.0f : 1.0f};
            pg8::gemm_phase<EpiRes, pg8::Sched>(F.lds + RING_OFF, 1024, 1024, 1024, S, E); } SEAM_L(pb + 7);
        if (PHON(8) && IN(pb + 8)) for (int rep = 0; rep < NREP(8); ++rep) { pg8::Sched S; S.init(MTOK, NGU, F.G, cid, HBp, DM, lw(ws, l, LW_W7), DM); EpiGlu E{RSW, ACTp, SSp}; pg8::gemm_phase<EpiGlu, pg8::Sched>(F.lds + RING_OFF, DM, DM, DM, S, E); } SEAM_L(pb + 8);
        if (PHON(9) && IN(pb + 9)) for (int rep = 0; rep < NREP(9); ++rep) { pg8::Sched S; S.init(MTOK, DM, F.G, cid, ACTp, DFF, lw(ws, l, LW_W8), DFF); EpiRes E{HBp, HLp, SSp, rep ? 0.0f : 0.5f}; pg8::gemm_phase<EpiRes, pg8::Sched>(F.lds + RING_OFF, DFF, DFF, DFF, S, E); } SEAM_L(pb + 9);
    }
    if (PHON(13) && IN(PH_FINAL)) { if (local_ok && LOCAL_BAR_ON) final_norm_phase(F, args, 8 * (cidl & 7) + ((cidl >> 3) & 7), cidl >> 6, RSW); else final_norm_phase(F, args, -1, 0, RSW); }
#undef IN
#undef SEAM
}

#ifndef MK_SPLIT
#define MK_SPLIT 0
#endif
extern "C" void kernel_launch(void* const* d_in, const int* in_sizes, int n_in, void* d_out, int out_size, void* d_ws, size_t ws_size, hipStream_t stream) {
    static int grid = 0;
    if (grid == 0) {
        if (n_in != 27 || in_sizes[0] != MTOK * DM || out_size != MTOK * DM || ws_size < WS_END) { fprintf(stderr, "kernel_launch: unexpected shapes (n_in %d, in0 %d, out %d, ws %zu < %zu)\n", n_in, n_in > 0 ? in_sizes[0] : -1, out_size, ws_size, (size_t)WS_END); grid = -1; return; }
        int dev = 0, cus = 0, per_cu = 0;
        if (hipGetDevice(&dev) != hipSuccess || hipDeviceGetAttribute(&cus, hipDeviceAttributeMultiprocessorCount, dev) != hipSuccess) { grid = -1; return; }
        if (hipFuncSetAttribute((const void*)fwd_kernel, hipFuncAttributeMaxDynamicSharedMemorySize, LDS_BYTES) != hipSuccess) { fprintf(stderr, "kernel_launch: hipFuncSetAttribute failed\n"); grid = -1; return; }
        if (hipOccupancyMaxActiveBlocksPerMultiprocessor(&per_cu, (const void*)fwd_kernel, 512, LDS_BYTES) != hipSuccess || per_cu < 1) fprintf(stderr, "kernel_launch: occupancy query reports %d\n", per_cu);
        (void)hipGetLastError();
        grid = cus;
    }
    if (grid < 0) return;
    if (hipMemsetAsync((char*)d_ws + WS_CTL, 0, CTL_ZERO_BYTES, stream) != hipSuccess) return;
    Args a{};
    for (int i = 0; i < 27; ++i) a.in[i] = (const float*)d_in[i];
    a.out = (float*)d_out; a.ws = (unsigned char*)d_ws;
#if MK_SPLIT
    for (int p = 0; p < NPHASE; ++p) { a.ph_lo = p; a.ph_hi = p + 1; hipLaunchKernelGGL(fwd_kernel, dim3(grid), dim3(512), LDS_BYTES, stream, a); }
#else
    a.ph_lo = 0; a.ph_hi = NPHASE; hipLaunchKernelGGL(fwd_kernel, dim3(grid), dim3(512), LDS_BYTES, stream, a);
#endif
    const hipError_t le = hipPeekAtLastError();
    if (le != hipSuccess) fprintf(stderr, "kernel_launch: launch failed: %s\n", hipGetErrorName(le));
}
```

```cpp
#include <hip/hip_runtime.h>
#include <cstdio>
#include <cstdint>

#define GAS __attribute__((address_space(1)))
#define LAS __attribute__((address_space(3)))
typedef unsigned short bf16_t;
typedef short bf16x8 __attribute__((ext_vector_type(8)));
typedef short s16x4 __attribute__((ext_vector_type(4)));
typedef float f32x2 __attribute__((ext_vector_type(2)));
typedef float f32x4 __attribute__((ext_vector_type(4)));
typedef float f32x16 __attribute__((ext_vector_type(16)));
typedef unsigned u32x2 __attribute__((ext_vector_type(2)));
typedef unsigned u32x4 __attribute__((ext_vector_type(4)));

constexpr int DM = 2048, BATCH = 4, SEQ = 4096, DEPTH = 4, MTOK = BATCH * SEQ;
constexpr int DFF = 5632, NGU = 2 * DFF;
constexpr int INC = 3904, INP = 4096;
constexpr int MEML = 256, MMEM = BATCH * MEML;
constexpr int QW = 1536, KVW = 2048;
constexpr float EPS = 1e-6f;
constexpr float LOG2E = 1.4426950408889634f;

__device__ __forceinline__ unsigned cvt_pk_bf16(float lo, float hi) { unsigned r; asm volatile("v_cvt_pk_bf16_f32 %0, %1, %2" : "=v"(r) : "v"(lo), "v"(hi)); return r; }
typedef __bf16 bf2_t __attribute__((ext_vector_type(2)));
__device__ __forceinline__ unsigned cvt_pk_bf16_c(float lo, float hi) { const f32x2 v = {lo, hi}; return __builtin_bit_cast(unsigned, __builtin_convertvector(v, bf2_t)); }
__device__ __forceinline__ float bf_lo(unsigned w) { return __uint_as_float(w << 16); }
__device__ __forceinline__ float bf_hi(unsigned w) { return __uint_as_float(w & 0xffff0000u); }
__device__ __forceinline__ unsigned ext_q(float h, unsigned hb16) { const int r = (int)(__float_as_uint(h) - hb16) >> 14; return (unsigned)(r > 1 ? 1 : r) & 3u; }
template <int F> __device__ __forceinline__ float ext_join(unsigned hb16, unsigned ew) { return __uint_as_float(hb16 + ((unsigned)__builtin_amdgcn_sbfe((int)ew, 2 * F, 2) << 14) + 0x2000u); }
__device__ __forceinline__ float fast_rcp(float x) { return __builtin_amdgcn_rcpf(x); }
__device__ __forceinline__ float silu_f(float x) { return x * fast_rcp(1.0f + __builtin_amdgcn_exp2f(-x * LOG2E)); }
__device__ __forceinline__ float gelu_f(float x) { const float u = x * (0.7978845608028654f + 0.035677408136300125f * x * x); return x * fast_rcp(1.0f + __builtin_amdgcn_exp2f(-2.0f * LOG2E * u)); }

namespace pg8 {
constexpr int BM = 256, BK = 64, HALF = 128, HTB = HALF * BK * 2  , STAGE_BYTES = 8 * HTB, NXCD = 8, WGM = 8;
__host__ __device__ __forceinline__ int lds_byte(int r, int c) { const int st = (r >> 4) * 2 + (c >> 5), rr = r & 15, cc = c & 31, ob = rr * 64 + cc * 2; return st * 1024 + (ob ^ (((ob >> 9) & 1) << 5)); }
__host__ __device__ __forceinline__ void stage_rc(int b, int& R, int& C) { const int st = b / 1024, sb = b % 1024, swz = sb ^ (((sb >> 9) & 1) << 5); R = (st >> 1) * 16 + swz / 64; C = (st & 1) * 32 + (swz % 64) / 2; }
__host__ __device__ __forceinline__ int perm32(int rho) { const int n = rho >> 4, i = rho & 15; return 8 * (i >> 2) + 4 * n + (i & 3); }

struct Unit { int pm, pn; const char* A; const char* B; size_t coff; };

struct Sched {
    int nM, nN, nwg, G, c;
    const char* A; const char* B; size_t atile, btile, bbatch; int bshift;
    __device__ void init(int M, int N, int G_, int c_, const void* A_, int lda, const void* B_, int ldb) {
        nM = M / BM; nN = N / BM; nwg = nM * nN; G = G_; c = c_; A = (const char*)A_; B = (const char*)B_; atile = (size_t)BM * lda * 2; btile = (size_t)BM * ldb * 2; bbatch = 0; bshift = 30; }
    __device__ bool next(int i, Unit& u) const {
        const long L = (long)i * G + c; if (L >= nwg) return false;
        int wgid = (int)L; { const int q = nwg / NXCD, r = nwg % NXCD, xcd = wgid % NXCD, off = wgid / NXCD; wgid = (xcd < r ? xcd * (q + 1) : r * (q + 1) + (xcd - r) * q) + off; }
        const int nig = WGM * nN, gid = wgid / nig, fm = gid * WGM, gsz = (nM - fm) < WGM ? (nM - fm) : WGM;
        u.pm = fm + ((wgid % nig) % gsz); u.pn = (wgid % nig) / gsz;
        u.A = A + (size_t)u.pm * atile; u.B = B + (size_t)u.pn * btile + (size_t)(u.pm >> bshift) * bbatch; u.coff = 0; return true;
    }
};

template <class Epi, class SchedT, bool ALIGN_EPI = true>
__device__ __forceinline__ void gemm_phase(LAS unsigned char* lds, const int K, const int lda, const int ldb, const SchedT& S, const Epi& E) {
    int tid = threadIdx.x; asm volatile("" : "+v"(tid));
    const int wid = __builtin_amdgcn_readfirstlane(tid >> 6), lane = tid & 63, wr = wid >> 2, wc = wid & 3, fr = lane & 15, fq = lane >> 4;
    int nt = K / BK; asm volatile("" : "+s"(nt));
    unsigned voffA[2], voffB[2];
#pragma unroll
    for (int i = 0; i < 2; ++i) { int R, C; stage_rc(tid * 16 + i * 8192, R, C); const int Rb = Epi::PERM ? ((R & ~31) + perm32(R & 31)) : R;
        voffA[i] = (unsigned)(R * lda + C) * 2u; voffB[i] = (unsigned)(Rb * ldb + C) * 2u; }
    const size_t kstep = (size_t)(BK * 2);
    const size_t hstepA = (size_t)HALF * lda * 2, hstepB = (size_t)HALF * ldb * 2;
    const unsigned ldsw = (unsigned)wid * 1024u;
    const int aoff = lds_byte(wr * 64 + fr, fq * 8), boff = lds_byte(wc * 32 + fr, fq * 8);
#define PG8_SA(b, h) (((b) * 2 + (h)) * HTB)
#define PG8_SB(b, h) ((4 + (b) * 2 + (h)) * HTB)
#define PG8_STAGE(bufoff, gbase, voff) do { _Pragma("unroll") for (int _i = 0; _i < 2; ++_i) \
        __builtin_amdgcn_global_load_lds((const unsigned*)((const char*)(gbase) + (voff)[_i]), (LAS unsigned*)(lds + (bufoff) + ldsw + _i * 8192), 16, 0, 0); } while (0)
#define PG8_LDA(dst, b, h) do { _Pragma("unroll") for (int m = 0; m < 4; ++m) _Pragma("unroll") for (int k = 0; k < 2; ++k) dst[m][k] = *(const LAS bf16x8*)(lds + PG8_SA(b, h) + aoff + m * 2048 + k * 1024); } while (0)
#define PG8_LDB(dst, b, h) do { _Pragma("unroll") for (int n = 0; n < 2; ++n) _Pragma("unroll") for (int k = 0; k < 2; ++k) dst[n][k] = *(const LAS bf16x8*)(lds + PG8_SB(b, h) + boff + n * 2048 + k * 1024); } while (0)
#define PG8_MMA(ai, bj, At, Bt) do { __builtin_amdgcn_s_setprio(1); _Pragma("unroll") for (int m = 0; m < 4; ++m) _Pragma("unroll") for (int n = 0; n < 2; ++n) _Pragma("unroll") for (int k = 0; k < 2; ++k) \
        acc[ai][bj][m][n] = __builtin_amdgcn_mfma_f32_16x16x32_bf16(Bt[n][k], At[m][k], acc[ai][bj][m][n], 0, 0, 0); __builtin_amdgcn_s_setprio(0); } while (0)
#define PG8_WAIT_V(n) asm volatile("s_waitcnt vmcnt(" #n ")" ::: "memory")
#define PG8_WAIT_L(n) asm volatile("s_waitcnt lgkmcnt(" #n ")" ::: "memory")
#define PG8_BAR __builtin_amdgcn_s_barrier()
#define PG8_SCHED __builtin_amdgcn_sched_barrier(0)
    Unit cur, nxt; int ui = 0, pm_prep = -1;
    if (!S.next(0, cur)) return;
    f32x4 acc[2][2][4][2];
#pragma unroll
    for (int a = 0; a < 2; ++a)
#pragma unroll
        for (int b = 0; b < 2; ++b)
#pragma unroll
            for (int m = 0; m < 4; ++m)
#pragma unroll
                for (int n = 0; n < 2; ++n) acc[a][b][m][n] = (f32x4){0.f, 0.f, 0.f, 0.f};
    bf16x8 At[4][2], B0[2][2], B1[2][2];
    const char* cA = cur.A; const char* cB = cur.B;
    PG8_STAGE(PG8_SB(0, 0), cB, voffB); PG8_STAGE(PG8_SB(0, 1), cB + hstepB, voffB); PG8_STAGE(PG8_SA(0, 0), cA, voffA); PG8_STAGE(PG8_SA(0, 1), cA + hstepA, voffA);
    E.prep(cur.pm, wr, lane); pm_prep = cur.pm;
    if (wr == 1) PG8_BAR;
    PG8_WAIT_V(2); PG8_BAR;
    PG8_STAGE(PG8_SB(1, 0), cB + kstep, voffB); PG8_STAGE(PG8_SA(1, 0), cA + kstep, voffA); PG8_STAGE(PG8_SB(1, 1), cB + hstepB + kstep, voffB);
    PG8_WAIT_V(6); PG8_BAR;
    for (;;) {
        const bool has_next = S.next(ui + 1, nxt);
        const char* nA = has_next ? nxt.A : cA; const char* nB = has_next ? nxt.B : cB;
#pragma clang loop unroll(disable)
        for (int t = 0; t < nt; t += 2) {
            const bool last = (t == nt - 2);
            const char* a1 = cA + (size_t)(t + 1) * kstep;
            const char* a2 = last ? nA : cA + (size_t)(t + 2) * kstep; const char* b2 = last ? nB : cB + (size_t)(t + 2) * kstep;
            const char* a3 = a2 + kstep; const char* b3 = b2 + kstep;
            PG8_LDB(B0, 0, 0); PG8_LDB(B1, 0, 1); PG8_SCHED; PG8_LDA(At, 0, 0); PG8_STAGE(PG8_SA(1, 1), a1 + hstepA, voffA);
            PG8_WAIT_V(8); PG8_WAIT_L(0); PG8_BAR; PG8_MMA(0, 0, At, B0); PG8_MMA(0, 1, At, B1); PG8_BAR; PG8_SCHED;
            PG8_LDA(At, 0, 1); PG8_STAGE(PG8_SB(0, 0), b2, voffB); PG8_STAGE(PG8_SB(0, 1), b2 + hstepB, voffB); PG8_STAGE(PG8_SA(0, 0), a2, voffA);
            PG8_WAIT_V(8); PG8_WAIT_L(0); PG8_BAR; PG8_MMA(1, 0, At, B0); PG8_MMA(1, 1, At, B1); PG8_BAR; PG8_SCHED;
            PG8_LDB(B0, 1, 0); PG8_LDB(B1, 1, 1); PG8_SCHED; PG8_LDA(At, 1, 0); PG8_STAGE(PG8_SA(0, 1), a2 + hstepA, voffA);
            PG8_WAIT_V(8); PG8_WAIT_L(0); PG8_BAR; PG8_MMA(0, 0, At, B0); PG8_MMA(0, 1, At, B1); PG8_BAR; PG8_SCHED;
            PG8_LDA(At, 1, 1); PG8_STAGE(PG8_SB(1, 0), b3, voffB); PG8_STAGE(PG8_SB(1, 1), b3 + hstepB, voffB); PG8_STAGE(PG8_SA(1, 0), a3, voffA);
            PG8_WAIT_V(8); PG8_WAIT_L(0); PG8_BAR; PG8_MMA(1, 0, At, B0); PG8_MMA(1, 1, At, B1); PG8_BAR; PG8_SCHED;
        }
        if constexpr (ALIGN_EPI) { if (wr == 0) PG8_BAR; }
        if (cur.pm != pm_prep) { E.prep(cur.pm, wr, lane); pm_prep = cur.pm; }
        { int fr_e = fr, fq_e = fq; asm volatile("" : "+v"(fr_e), "+v"(fq_e));
          E(acc, cur, wr, wc, fr_e, fq_e); }
        if (!has_next) break;
#pragma unroll
        for (int a = 0; a < 2; ++a)
#pragma unroll
            for (int b = 0; b < 2; ++b)
#pragma unroll
                for (int m = 0; m < 4; ++m)
#pragma unroll
                    for (int n = 0; n < 2; ++n) acc[a][b][m][n] = (f32x4){0.f, 0.f, 0.f, 0.f};
        cur = nxt; cA = nA; cB = nB; ++ui;
        if constexpr (ALIGN_EPI) { if (wr == 1) PG8_BAR; }
    }
    PG8_WAIT_V(0);
    if constexpr (!ALIGN_EPI) { if (wr == 0) PG8_BAR; }
    PG8_BAR;
#undef PG8_SA
#undef PG8_SB
#undef PG8_STAGE
#undef PG8_LDA
#undef PG8_LDB
#undef PG8_MMA
#undef PG8_WAIT_V
#undef PG8_WAIT_L
#undef PG8_BAR
#undef PG8_SCHED
}
}
using pg8::Unit;
#ifndef EPI_NT
#define EPI_NT 0
#endif
#if EPI_NT
#define ST16(p, v) __builtin_nontemporal_store((v), (GAS u32x4*)(p))
#define ST8(p, v) __builtin_nontemporal_store((v), (GAS u32x2*)(p))
#else
#define ST16(p, v) (*(GAS u32x4*)(p) = (v))
#define ST8(p, v) (*(GAS u32x2*)(p) = (v))
#endif
typedef f32x4 (&AccRef)[2][2][4][2];
#define EPI_ROWS  _Pragma("unroll") for (int ai = 0; ai < 2; ++ai) _Pragma("unroll") for (int m = 0; m < 4; ++m)
__device__ __forceinline__ u32x4 pack8(const f32x4 a, const f32x4 b) { u32x4 w; w.x = cvt_pk_bf16(a[0], a[1]); w.y = cvt_pk_bf16(a[2], a[3]); w.z = cvt_pk_bf16(b[0], b[1]); w.w = cvt_pk_bf16(b[2], b[3]); return w; }
__device__ __forceinline__ float dot4(const f32x4 a) { return (a[0] * a[0] + a[1] * a[1]) + (a[2] * a[2] + a[3] * a[3]); }
__device__ __forceinline__ float quad_sum(float s) { s += __shfl_xor(s, 16); s += __shfl_xor(s, 32); return s; }

template <int NP> __device__ __forceinline__ void rstd_prep(const float* ss, int pm, int wr, int lane, float invn, LAS float* rsw) {
#pragma unroll
    for (int i = 0; i < 2; ++i) { const int row = pm * 256 + 128 * i + 64 * wr + lane; const GAS float* p = (const GAS float*)ss + (size_t)row * NP; float s = 0.f;
#pragma unroll
        for (int j = 0; j < NP / 4; ++j) { const f32x4 a = *(const GAS f32x4*)(p + 4 * j); s += (a[0] + a[1]) + (a[2] + a[3]); }
        rsw[64 * i + lane] = __builtin_amdgcn_rsqf(s * invn + EPS); }
    asm volatile("s_waitcnt lgkmcnt(0)" ::: "memory");
}
__device__ __forceinline__ void rstd_fetch(const LAS float* rsw, int fr, float (&rs)[2][4]) { EPI_ROWS rs[ai][m] = rsw[64 * ai + 16 * m + fr]; }

struct EpiGlu {
    static constexpr bool PERM = true;
    LAS float* rsw; __device__ __forceinline__ void prep(int pm, int wr, int lane) const { rstd_prep<32>(ss, pm, wr, lane, 1.0f / DM, rsw); }
    bf16_t* O; const float* ss;
    __device__ __forceinline__ void operator()(AccRef acc, const Unit& u, int wr, int wc, int fr, int fq) const {
        const int rowb = u.pm * 256 + wr * 64 + fr; float rs[2][4]; rstd_fetch(rsw, fr, rs);
        const int col0 = u.pn * 128 + wc * 32 + 8 * fq;
        EPI_ROWS { const float r = rs[ai][m], rl = -r * LOG2E, rr = r * r; f32x4 o[2];
#pragma unroll
            for (int n = 0; n < 2; ++n) { const f32x4 g = acc[ai][0][m][n], u = acc[ai][1][m][n]; const f32x4 a = g * rl; f32x4 e;
#pragma unroll
                for (int k = 0; k < 4; ++k) e[k] = __builtin_amdgcn_exp2f(a[k]);
                const f32x4 den = e + 1.0f; f32x4 rc;
#pragma unroll
                for (int k = 0; k < 4; ++k) rc[k] = fast_rcp(den[k]);
                o[n] = (g * u) * (rc * rr); }
            ST16((O + (size_t)(rowb + 128 * ai + 16 * m) * DFF + col0), pack8(o[0], o[1])); }
    }
};

struct EpiRes {
    static constexpr bool PERM = true;
    __device__ __forceinline__ void prep(int, int, int) const {}
    bf16_t* HB; unsigned* HE; float* ss; float alpha;
    __device__ __forceinline__ void operator()(AccRef acc, const Unit& u, int wr, int wc, int fr, int fq) const {
        const int rowb = u.pm * 256 + wr * 64 + fr, col0 = u.pn * 256 + wc * 32 + 8 * fq;
        GAS u32x4* ep = (GAS u32x4*)((GAS unsigned*)HE + (((size_t)((u.pm * 8 + u.pn) * 8 + wr * 4 + wc) * 64) + fq * 16 + fr) * 8);
        const u32x4 ein[2] = {ep[0], ep[1]}; u32x4 eout[2];
        EPI_ROWS { const int row = rowb + 128 * ai + 16 * m; float sq = 0.f; const unsigned ew = ein[ai][m]; unsigned eo = 0u;
#pragma unroll
            for (int bj = 0; bj < 2; ++bj) { const size_t o = (size_t)row * DM + col0 + 128 * bj; GAS u32x4* hp = (GAS u32x4*)(HB + o); const u32x4 v = *hp; u32x4 wout;
#define EPR_PAIR(i) { const unsigned w = v[i]; const float x0 = bj ? ext_join<8 + 2 * i>(w << 16, ew) : ext_join<2 * i>(w << 16, ew), x1 = bj ? ext_join<9 + 2 * i>(w & 0xffff0000u, ew) : ext_join<1 + 2 * i>(w & 0xffff0000u, ew); \
                    const unsigned u0 = __float_as_uint(x0 + acc[ai][bj][m][i >> 1][2 * (i & 1)] * alpha) | 1u, u1 = __float_as_uint(x1 + acc[ai][bj][m][i >> 1][2 * (i & 1) + 1] * alpha) | 1u; \
                    const float h0 = __uint_as_float(u0), h1 = __uint_as_float(u1); sq += h0 * h0 + h1 * h1; wout[i] = cvt_pk_bf16(h0, h1); \
                    eo |= __builtin_amdgcn_ubfe(u0, 14, 2) << (2 * (8 * bj + 2 * i)); eo |= __builtin_amdgcn_ubfe(u1, 14, 2) << (2 * (8 * bj + 2 * i + 1)); }
                EPR_PAIR(0) EPR_PAIR(1) EPR_PAIR(2) EPR_PAIR(3)
#undef EPR_PAIR
                *hp = wout; }
            eout[ai][m] = eo;
            sq = quad_sum(sq); if (fq == 0) ((GAS float*)ss)[(size_t)row * 32 + u.pn * 4 + wc] = sq; }
        ep[0] = eout[0]; ep[1] = eout[1];
    }
};

struct EpiPlain {
    static constexpr bool PERM = true;
    __device__ __forceinline__ void prep(int, int, int) const {}
    bf16_t* O; int ldc;
    __device__ __forceinline__ void operator()(AccRef acc, const Unit& u, int wr, int wc, int fr, int fq) const {
        const int rowb = u.pm * 256 + wr * 64 + fr, col0 = u.pn * 256 + wc * 32 + 8 * fq;
        EPI_ROWS { bf16_t* rp = O + u.coff + (size_t)(rowb + 128 * ai + 16 * m) * ldc + col0;
#pragma unroll
            for (int bj = 0; bj < 2; ++bj) ST16((rp + 128 * bj), pack8(acc[ai][bj][m][0], acc[ai][bj][m][1])); }
    }
};

struct EpiMix {
    static constexpr bool PERM = true;
    LAS float* rsw; __device__ __forceinline__ void prep(int pm, int wr, int lane) const { rstd_prep<32>(ss, pm, wr, lane, 1.0f / DM, rsw); }
    bf16_t* P; const float* ss; float* ssv; float* ssq; float* ssk; const float* c128; const float* s128; const float* c64; const float* s64;
    __device__ __forceinline__ void operator()(AccRef acc, const Unit& u, int wr, int wc, int fr, int fq) const {
        const int rowb = u.pm * 256 + wr * 64 + fr; float rs[2][4]; rstd_fetch(rsw, fr, rs);
        const int pn = u.pn;
        if (pn >= 4 && pn < 8) {
            const bool isk = pn >= 6; const int head = 2 * (pn & 1) + (wc >> 1), d0 = 32 * (wc & 1) + 8 * fq;
            const float l2g = log2f(1.0f - exp2f(-5.0f - (float)head));
            const int cbase = (isk ? 1536 : 1024) + 128 * head + d0;
            EPI_ROWS { const int row = rowb + 128 * ai + 16 * m, pos = row & (SEQ - 1), pi = pos & 127; const float r = rs[ai][m];
                const float sc = isk ? 0.08838834764831845f * exp2f((float)(127 - pi) * l2g) : exp2f((float)pi * l2g);
                const GAS float* cp = (const GAS float*)c128 + (size_t)pos * 64 + d0; const GAS float* sp = (const GAS float*)s128 + (size_t)pos * 64 + d0;
                f32x4 o1[2], o2[2];
#pragma unroll
                for (int n = 0; n < 2; ++n) { const f32x4 c = *(const GAS f32x4*)(cp + 4 * n), s = *(const GAS f32x4*)(sp + 4 * n); const f32x4 x1 = acc[ai][0][m][n] * r, x2 = acc[ai][1][m][n] * r;
                    o1[n] = (x1 * c - x2 * s) * sc; o2[n] = (x2 * c + x1 * s) * sc; }
                bf16_t* rp = P + (size_t)row * INP + cbase; ST16(rp, pack8(o1[0], o1[1])); ST16((rp + 64), pack8(o2[0], o2[1])); }
        } else if (pn == 15) {
            if (wc == 0) { const int d0 = 8 * fq;
                EPI_ROWS { const int row = rowb + 128 * ai + 16 * m, pos = row & (SEQ - 1); const float r = rs[ai][m];
                    const GAS float* cp = (const GAS float*)c64 + (size_t)pos * 32 + d0; const GAS float* sp = (const GAS float*)s64 + (size_t)pos * 32 + d0;
                    f32x4 o1[2], o2[2];
#pragma unroll
                    for (int n = 0; n < 2; ++n) { const f32x4 c = *(const GAS f32x4*)(cp + 4 * n), s = *(const GAS f32x4*)(sp + 4 * n); const f32x4 x1 = acc[ai][0][m][n] * r, x2 = acc[ai][1][m][n] * r;
                        o1[n] = x1 * c - x2 * s; o2[n] = x2 * c + x1 * s; }
                    bf16_t* rp = P + (size_t)row * INP + 3840 + d0; ST16(rp, pack8(o1[0], o1[1])); ST16((rp + 32), pack8(o2[0], o2[1])); } }
        } else {
            const int act = pn < 4 ? 1 : ((pn == 10 || pn == 11) ? 2 : 0); const int col0 = pn * 256 + wc * 32 + 8 * fq;
            float* sq_out = nullptr; int sq_np = 0, sq_idx = 0;
            if (pn == 2 || pn == 3) { sq_out = ssv; sq_np = 8; sq_idx = (pn - 2) * 4 + wc; } else if (pn == 12 || pn == 13) { sq_out = ssq; sq_np = 8; sq_idx = (pn - 12) * 4 + wc; } else if (pn == 14) { sq_out = ssk; sq_np = 4; sq_idx = wc; }
            EPI_ROWS { const int row = rowb + 128 * ai + 16 * m; const float r = rs[ai][m]; float sq = 0.f;
#pragma unroll
                for (int bj = 0; bj < 2; ++bj) { f32x4 v0 = acc[ai][bj][m][0] * r, v1 = acc[ai][bj][m][1] * r;
                    if (act == 1) {
#pragma unroll
                        for (int e = 0; e < 4; ++e) { v0[e] = gelu_f(v0[e]); v1[e] = gelu_f(v1[e]); } }
                    else if (act == 2) {
#pragma unroll
                        for (int e = 0; e < 4; ++e) { v0[e] = silu_f(v0[e]); v1[e] = silu_f(v1[e]); } }
                    sq += dot4(v0) + dot4(v1);
                    ST16((P + (size_t)row * INP + col0 + 128 * bj), pack8(v0, v1)); }
                if (sq_out) { sq = quad_sum(sq); if (fq == 0) ((GAS float*)sq_out)[(size_t)row * sq_np + sq_idx] = sq; } }
        }
    }
};

struct EpiQ {
    static constexpr bool PERM = true;
    LAS float* rsw; __device__ __forceinline__ void prep(int pm, int wr, int lane) const { rstd_prep<8>(ssq, pm, wr, lane, 1.0f / 512.0f, rsw); }
    bf16_t* Q; const float* ssq; const float* c64; const float* s64;
    __device__ __forceinline__ void operator()(AccRef acc, const Unit& u, int wr, int wc, int fr, int fq) const {
        const int rowb = u.pm * 256 + wr * 64 + fr; float rs[2][4]; rstd_fetch(rsw, fr, rs);
        const float qs = 0.07216878364870322f * LOG2E;
        if (u.pn < 4) {
            EPI_ROWS { const float r = rs[ai][m] * qs; bf16_t* rp = Q + (size_t)(rowb + 128 * ai + 16 * m) * QW + 192 * (2 * u.pn) + wc * 32 + 8 * fq;
#pragma unroll
                for (int bj = 0; bj < 2; ++bj) ST16((rp + 192 * bj), pack8(acc[ai][bj][m][0] * r, acc[ai][bj][m][1] * r)); }
        } else { const int head = 4 * (u.pn - 4) + wc, d0 = 8 * fq;
            EPI_ROWS { const int row = rowb + 128 * ai + 16 * m, pos = row & (SEQ - 1); const float r = rs[ai][m] * qs;
                const GAS float* cp = (const GAS float*)c64 + (size_t)pos * 32 + d0; const GAS float* sp = (const GAS float*)s64 + (size_t)pos * 32 + d0;
                f32x4 o1[2], o2[2];
#pragma unroll
                for (int n = 0; n < 2; ++n) { const f32x4 c = *(const GAS f32x4*)(cp + 4 * n), s = *(const GAS f32x4*)(sp + 4 * n); const f32x4 x1 = acc[ai][0][m][n] * r, x2 = acc[ai][1][m][n] * r;
                    o1[n] = x1 * c - x2 * s; o2[n] = x2 * c + x1 * s; }
                bf16_t* rp = Q + (size_t)row * QW + 192 * head + 128 + d0; ST16(rp, pack8(o1[0], o1[1])); ST16((rp + 32), pack8(o2[0], o2[1])); }
        }
    }
};

struct EpiKV {
    static constexpr bool PERM = true;
    LAS float* rsw; __device__ __forceinline__ void prep(int pm, int wr, int lane) const { rstd_prep<4>(ssk, pm, wr, lane, 1.0f / 256.0f, rsw); }
    bf16_t* KN; const float* ssk;
    __device__ __forceinline__ void operator()(AccRef acc, const Unit& u, int wr, int wc, int fr, int fq) const {
        const int rowb = u.pm * 256 + wr * 64 + fr; float rs[2][4]; rstd_fetch(rsw, fr, rs);
        const int col0 = 128 * u.pn + wc * 32 + 8 * fq;
        EPI_ROWS { const float r = rs[ai][m]; bf16_t* rp = KN + (size_t)(rowb + 128 * ai + 16 * m) * 1024 + col0;
#pragma unroll
            for (int bj = 0; bj < 2; ++bj) ST16((rp + (size_t)bj * ((size_t)MTOK * 1024)), pack8(acc[ai][bj][m][0] * r, acc[ai][bj][m][1] * r)); }
    }
};

struct EpiSm {
    static constexpr bool PERM = true;
    LAS float* rsw; __device__ __forceinline__ void prep(int pm, int wr, int lane) const { rstd_prep<32>(ss, pm, wr, lane, 1.0f / DM, rsw); }
    bf16_t* PX; const float* ss; LAS float* xl;
    __device__ __forceinline__ void operator()(AccRef acc, const Unit& u, int wr, int wc, int fr, int fq) const {
        const int rowb = u.pm * 256 + wr * 64 + fr; float rs[2][4]; rstd_fetch(rsw, fr, rs);
        const float sc = 0.044194173824159216f * LOG2E;
        float mx[2][4];
        EPI_ROWS { float v = -3.0e38f;
#pragma unroll
            for (int bj = 0; bj < 2; ++bj)
#pragma unroll
                for (int n = 0; n < 2; ++n)
#pragma unroll
                    for (int e = 0; e < 4; ++e) v = fmaxf(v, acc[ai][bj][m][n][e]);
            v = fmaxf(v, __shfl_xor(v, 16)); v = fmaxf(v, __shfl_xor(v, 32)); mx[ai][m] = v;
            if (fq == 0) xl[(wr * 64 + 128 * ai + 16 * m + fr) * 4 + wc] = v; }
        asm volatile("s_waitcnt lgkmcnt(0)" ::: "memory"); __builtin_amdgcn_s_barrier(); asm volatile("" ::: "memory");
        EPI_ROWS { const f32x4 t = *(const LAS f32x4*)(xl + (wr * 64 + 128 * ai + 16 * m + fr) * 4); const float r = rs[ai][m] * sc;
            mx[ai][m] = fmaxf(fmaxf(t[0], t[1]), fmaxf(t[2], t[3])) * r; }
        EPI_ROWS { const float r = rs[ai][m] * sc, mr = mx[ai][m]; float s = 0.f;
#pragma unroll
            for (int bj = 0; bj < 2; ++bj)
#pragma unroll
                for (int n = 0; n < 2; ++n) { f32x4 q;
#pragma unroll
                    for (int e = 0; e < 4; ++e) { q[e] = __builtin_amdgcn_exp2f(acc[ai][bj][m][n][e] * r - mr); s += q[e]; }
                    acc[ai][bj][m][n] = q; }
            s = quad_sum(s);
            if (fq == 0) xl[1024 + (wr * 64 + 128 * ai + 16 * m + fr) * 4 + wc] = s; }
        asm volatile("s_waitcnt lgkmcnt(0)" ::: "memory"); __builtin_amdgcn_s_barrier(); asm volatile("" ::: "memory");
        const int col0 = 256 * u.pn + wc * 32 + 8 * fq;
        EPI_ROWS { const f32x4 t = *(const LAS f32x4*)(xl + 1024 + (wr * 64 + 128 * ai + 16 * m + fr) * 4); const float inv = fast_rcp((t[0] + t[1]) + (t[2] + t[3]));
            bf16_t* rp = PX + (size_t)(rowb + 128 * ai + 16 * m) * 1024 + col0;
#pragma unroll
            for (int bj = 0; bj < 2; ++bj) ST16((rp + 128 * bj), pack8(acc[ai][bj][m][0] * inv, acc[ai][bj][m][1] * inv)); }
        asm volatile("s_waitcnt lgkmcnt(0)" ::: "memory"); __builtin_amdgcn_s_barrier(); asm volatile("" ::: "memory");
    }
};
constexpr size_t MiB = 1u << 20;
constexpr size_t WS_CTL = 0, CTL_ZERO_BYTES = 1 * MiB;
constexpr size_t WS_TAB = 1 * MiB;
constexpr size_t TAB_C128 = WS_TAB, TAB_S128 = WS_TAB + 1 * MiB, TAB_C64 = WS_TAB + 2 * MiB, TAB_S64 = WS_TAB + 2 * MiB + 512 * 1024;
constexpr size_t WS_SS = 4 * MiB;
constexpr size_t WS_SSV = 6 * MiB, WS_SSQ = WS_SSV + 512 * 1024, WS_SSK = WS_SSQ + 512 * 1024;
constexpr size_t WS_H = 8 * MiB;
constexpr size_t WS_KVS = WS_H + 32 * MiB, WS_PREV = WS_H + 64 * MiB;
constexpr size_t WS_HB = WS_H + 128 * MiB;
constexpr size_t WS_ACT = WS_HB + 64 * MiB;
constexpr size_t WS_KN = WS_ACT + 176 * MiB, WS_VV = WS_KN + 32 * MiB, WS_YC = WS_VV + 32 * MiB;
constexpr size_t WS_PX = WS_KN;
constexpr size_t WS_LW = WS_YC + 64 * MiB;
constexpr size_t WS_WQG = WS_ACT, WS_WKVT = WS_ACT + 32 * MiB, WS_WOT = WS_ACT + 96 * MiB, WS_KVM = WS_ACT + 128 * MiB, WS_MEMN = WS_ACT + 160 * MiB;
constexpr size_t LW_W1 = 0, LW_W2 = 44 * MiB, LW_W7 = 66 * MiB, LW_W8 = 110 * MiB, LW_WIN = 132 * MiB, LW_WUQ = 148 * MiB, LW_WUKV = LW_WUQ + 3 * MiB / 2, LW_WOUT = LW_WUKV + MiB,
                 LW_BTS = LW_WOUT + 8 * MiB, LW_BTO = LW_BTS + 16 * MiB, LW_WST = LW_BTO + 16 * MiB, LW_STRIDE = LW_WST + MiB;
constexpr size_t WS_PROJ = WS_LW + DEPTH * LW_STRIDE, WS_QM = WS_PROJ + 128 * MiB;
constexpr size_t WS_END = WS_QM + 48 * MiB;
static_assert(WS_VV == WS_KN + (size_t)MTOK * 1024 * 2 && LW_WUKV + MiB == LW_WOUT && (size_t)NGU * DM * 2 == 44 * MiB && (size_t)DM * DFF * 2 == 22 * MiB && (size_t)MTOK * DFF * 2 == 176 * MiB, "ws map");
constexpr int CW_BAR = 4096;
constexpr int CW_QUEUE = 16384;

constexpr int RING_OFF = 0, RING_BYTES = 131072;
constexpr int XL_OFF = RING_BYTES;
constexpr int MISC_OFF = RING_BYTES + 8192;
constexpr int RSW_OFF = MISC_OFF + 256;
constexpr int LDS_BYTES = 147456;

#define RLX_AGENT __ATOMIC_RELAXED, __HIP_MEMORY_SCOPE_AGENT
#define LDS_WAIT() asm volatile("s_waitcnt lgkmcnt(0)" ::: "memory")
#define VM_WAIT() asm volatile("s_waitcnt vmcnt(0)" ::: "memory")

#define XB_TMO      128
#define XB_XCNT(j)  (256  + 64 * (j))
#define XB_XSUB(j)  (1280 + 64 * (j))
#define XB_XGEN(j)  (2304 + 64 * (j))
#define XB_TOP      3328
#define XB_TOPGEN   3392
#define XB_LCNT(j)  (3456 + 64 * (j))
#define XB_TOP2(p)    (7616 + 64 * (p))
#define XB_TOPGEN2(p) (7872 + 64 * (p))
#define XCD_BAR_WORDS 8128
#define XB_SPIN_CAP (1u << 22)

__device__ __forceinline__ unsigned xb_ld(unsigned* p)              { return __hip_atomic_load(p, __ATOMIC_RELAXED, __HIP_MEMORY_SCOPE_AGENT); }
__device__ __forceinline__ unsigned xb_add(unsigned* p, unsigned v) { return __hip_atomic_fetch_add(p, v, __ATOMIC_RELAXED, __HIP_MEMORY_SCOPE_AGENT); }
__device__ __forceinline__ unsigned xb_xcc_id() { return (unsigned)__builtin_amdgcn_s_getreg((3 << 11) | 20) & 0xFu; }
#define XB_SPIN(cond, bar) do { unsigned _sp = 0; while (cond) { __builtin_amdgcn_s_sleep(1); \
    if ((++_sp & 255u) == 0u) { if (xb_ld(&(bar)[XB_TMO])) break; if (_sp > XB_SPIN_CAP) { atomicAdd(&(bar)[XB_TMO], 1u); break; } } } } while (0)

struct XcdBarrier { unsigned* bar; unsigned x; volatile LAS unsigned* st; };

__device__ __forceinline__ XcdBarrier xcd_barrier_post(unsigned* bar, volatile LAS unsigned* st) {
    XcdBarrier b; b.bar = bar; b.x = xb_xcc_id(); b.st = st;
    if (threadIdx.x == 0) st[2] = xb_add(&bar[XB_XCNT(b.x)], 1u);
    return b;
}
__device__ __forceinline__ void xcd_barrier_complete(unsigned* bar, unsigned x, unsigned& nloc, unsigned& nx) {
    const unsigned G = gridDim.x * gridDim.y * gridDim.z;
    unsigned sum, cnt, mine, sp = 0u;
    for (;;) {
        sum = 0u; cnt = 0u; mine = 0u;
#pragma unroll
        for (unsigned j = 0; j < 16; ++j) { const unsigned c = xb_ld(&bar[XB_XCNT(j)]); sum += c; cnt += (c > 0u) ? 1u : 0u; mine = (j == x) ? c : mine; }
        if (sum == G) break;
        __builtin_amdgcn_s_sleep(1);
        if ((++sp & 255u) == 0u) { if (xb_ld(&bar[XB_TMO])) break; if (sp > XB_SPIN_CAP) { atomicAdd(&bar[XB_TMO], 1u); break; } }
    }
    nloc = mine > 0u ? mine : 1u; nx = cnt > 0u ? cnt : 1u;
}
__device__ __forceinline__ void xcd_barrier(const XcdBarrier& b, const int top = XB_TOP, const int topgen = XB_TOPGEN, const unsigned nx_sub = 0u) {
    asm volatile("s_waitcnt vmcnt(0)" ::: "memory");
    __syncthreads();
    if (threadIdx.x == 0) {
        unsigned* bar = b.bar;
        __builtin_amdgcn_s_waitcnt(0);
        unsigned nloc = b.st[0], nx = b.st[1];
        if (nloc == 0u) { xcd_barrier_complete(bar, b.x, nloc, nx); b.st[0] = nloc; b.st[1] = nx; }
        if (nx_sub) nx = nx_sub;
        const unsigned old = xb_add(&bar[XB_XSUB(b.x)], 1u);
        const unsigned gen = old / nloc;
        if (old + 1u == (gen + 1u) * nloc) {
            __builtin_amdgcn_fence(__ATOMIC_RELEASE, "agent");
            asm volatile("s_waitcnt vmcnt(0)" ::: "memory");
            const unsigned og = xb_add(&bar[top], 1u);
            const unsigned tg = og / nx;
            if (og + 1u == (tg + 1u) * nx) xb_add(&bar[topgen], 1u);
            else XB_SPIN(xb_ld(&bar[topgen]) == tg, bar);
            __builtin_amdgcn_fence(__ATOMIC_ACQUIRE, "agent");
            xb_add(&bar[XB_XGEN(b.x)], 1u);
            asm volatile("s_waitcnt vmcnt(0)" ::: "memory");
        } else {
            XB_SPIN(xb_ld(&bar[XB_XGEN(b.x)]) == gen, bar);
            __builtin_amdgcn_fence(__ATOMIC_ACQUIRE, "agent");
            asm volatile("s_waitcnt vmcnt(0)" ::: "memory");
        }
    }
    __syncthreads();
}

#ifndef LOCAL_BAR_RELEASE
#define LOCAL_BAR_RELEASE 0
#endif
__device__ __forceinline__ void xcc_local_barrier(unsigned* bar, unsigned x, unsigned n) {
    asm volatile("s_waitcnt vmcnt(0)" ::: "memory");
    __syncthreads();
    if (threadIdx.x == 0) {
        __builtin_amdgcn_s_waitcnt(0);
        unsigned* cnt = &bar[XB_LCNT(x)];
#if LOCAL_BAR_RELEASE
        __builtin_amdgcn_fence(__ATOMIC_RELEASE, "agent"); asm volatile("s_waitcnt vmcnt(0)" ::: "memory");
#endif
        const unsigned old = xb_add(cnt, 1u), target = (old / n + 1u) * n;
        XB_SPIN(xb_ld(cnt) < target, bar);
        __builtin_amdgcn_fence(__ATOMIC_ACQUIRE, "agent");
        asm volatile("s_waitcnt vmcnt(0)" ::: "memory");
    }
    __syncthreads();
}

struct Frame {
    LAS unsigned char* lds;
    volatile LAS unsigned* MISC;
    unsigned* ctl;
    unsigned char* ws;
    int tid, lane, wave, vcu, G;
};
__device__ __forceinline__ float wave_sum(float v) {
#pragma unroll
    for (int o = 1; o < 64; o <<= 1) v += __shfl_xor(v, o);
    return v;
}
__device__ __forceinline__ unsigned f2bf(float f) { unsigned u = __builtin_bit_cast(unsigned, f); return (u + 0x7fffu + ((u >> 16) & 1u)) >> 16; }
__device__ __forceinline__ unsigned pk2(float lo, float hi) { return f2bf(lo) | (f2bf(hi) << 16); }

__device__ __forceinline__ void xpose_item(const float* W, int Nsrc, int K, bf16_t* WT, const float* gain, int k0, int n0, int sc0, int sc1, LAS unsigned* scr, int lane) {
    const int c4 = lane & 15, rp = lane >> 4; const int scb = (c4 >= 8) ? sc1 : sc0; const bool valid = scb >= 0; const int sc = scb + ((4 * c4) & 31);
    f32x4 ra[8], rb[8];
#pragma unroll
    for (int i = 0; i < 8; ++i) { const int k = k0 + 2 * (4 * i + rp);
        if (valid) { ra[i] = *(const GAS f32x4*)(W + (size_t)k * Nsrc + sc); rb[i] = *(const GAS f32x4*)(W + (size_t)(k + 1) * Nsrc + sc); } else { ra[i] = (f32x4){0.f, 0.f, 0.f, 0.f}; rb[i] = ra[i]; } }
#pragma unroll
    for (int i = 0; i < 8; ++i) { const int kp = 4 * i + rp, k = k0 + 2 * kp; float ga = 1.f, gb = 1.f; if (gain) { ga = ((const GAS float*)gain)[k]; gb = ((const GAS float*)gain)[k + 1]; }
        u32x4 w; w.x = cvt_pk_bf16(ra[i][0] * ga, rb[i][0] * gb); w.y = cvt_pk_bf16(ra[i][1] * ga, rb[i][1] * gb); w.z = cvt_pk_bf16(ra[i][2] * ga, rb[i][2] * gb); w.w = cvt_pk_bf16(ra[i][3] * ga, rb[i][3] * gb);
        *(LAS u32x4*)(scr + ((kp >> 2) + 8 * (kp & 3)) * 68 + 4 * c4) = w; }
    LDS_WAIT(); asm volatile("" ::: "memory");
    const int c = lane & 7;
#pragma unroll
    for (int j = 0; j < 8; ++j) { const int n = 8 * j + (lane >> 3); const LAS unsigned* s = scr + c * 68 + n;
        u32x4 o; o.x = s[0]; o.y = s[8 * 68]; o.z = s[16 * 68]; o.w = s[24 * 68];
        *(GAS u32x4*)(WT + (size_t)(n0 + n) * K + k0 + 8 * c) = o; }
    LDS_WAIT(); asm volatile("" ::: "memory");
}
__device__ __forceinline__ int map_win(int n0) {
    const int t = n0 >> 8, tc = n0 & 255;
    if (t >= 4 && t < 8) { const int s = tc >> 7, j = tc & 127; return (t < 6 ? 1024 : 1536) + 128 * (2 * (t & 1) + (j >> 6)) + 64 * s + (j & 63); }
    if (t == 15) { if (tc == 0) return 3840; if (tc == 128) return 3872; return -1; }
    return n0;
}
__device__ __forceinline__ int map_wuq(int n0) {
    const int t = n0 >> 8, tc = n0 & 255;
    if (t < 4) return 192 * (2 * t + (tc >> 7)) + (tc & 127);
    const int s = tc >> 7, j = tc & 127; return 192 * (4 * (t - 4) + (j >> 5)) + 128 + 32 * s + (j & 31);
}
struct Args { const float* in[27]; float* out; unsigned char* ws; int ph_lo, ph_hi; };
enum { I_X = 0, I_MEM, I_F1N, I_F1G, I_F1U, I_F1D, I_MIXN, I_WIN, I_SGUN, I_SGUW, I_SGUB, I_RETGN, I_QN, I_WUQ, I_KVN, I_WUKV, I_WOUT, I_XAN, I_MEMN, I_XAWQ, I_XAWKV, I_XAWO, I_F2N, I_F2G, I_F2U, I_F2D, I_FIN };

__device__ __forceinline__ bf16_t* lw(unsigned char* ws, int l, size_t off) { return (bf16_t*)(ws + WS_LW + (size_t)l * LW_STRIDE + off); }

__device__ __forceinline__ void p0_prologue(Frame& F, const Args& a) {
    LAS unsigned* scr = (LAS unsigned*)(F.lds + RING_OFF + F.wave * 16384);
    const int gw = F.vcu * 8 + F.wave, NGW = F.G * 8;
    constexpr int I_1 = 32 * 176, I_2 = 88 * 32, I_IN = 32 * 64, I_UQ = 8 * 24, I_UKV = 4 * 32, I_SQ = 32 * 32, I_KV = 32 * 64;
    constexpr int PER_LAYER = 2 * I_1 + 2 * I_2 + I_IN + I_UQ + I_UKV + I_SQ + I_KV + I_SQ;
    for (int it = gw; it < DEPTH * PER_LAYER; it += NGW) {
        const int l = it / PER_LAYER; int r = it % PER_LAYER;
        if (r < 2 * I_1) { const bool f2 = r >= I_1; if (f2) r -= I_1; const int kb = r / 176, nb = r % 176, n0 = nb * 64; const bool up = (n0 >> 7) & 1; const int sc = 128 * (n0 >> 8) + (n0 & 127);
            const float* W = a.in[f2 ? (up ? I_F2U : I_F2G) : (up ? I_F1U : I_F1G)] + (size_t)l * DM * DFF;
            xpose_item(W, DFF, DM, lw(F.ws, l, f2 ? LW_W7 : LW_W1), a.in[f2 ? I_F2N : I_F1N] + l * DM, kb * 64, n0, sc, sc + 32, scr, F.lane); continue; }
        r -= 2 * I_1;
        if (r < 2 * I_2) { const bool f2 = r >= I_2; if (f2) r -= I_2; const int kb = r / 32, nb = r % 32;
            xpose_item(a.in[f2 ? I_F2D : I_F1D] + (size_t)l * DFF * DM, DM, DFF, lw(F.ws, l, f2 ? LW_W8 : LW_W2), nullptr, kb * 64, nb * 64, nb * 64, nb * 64 + 32, scr, F.lane); continue; }
        r -= 2 * I_2;
        if (r < I_IN) { const int kb = r / 64, nb = r % 64;
            xpose_item(a.in[I_WIN] + (size_t)l * DM * INC, INC, DM, lw(F.ws, l, LW_WIN), a.in[I_MIXN] + l * DM, kb * 64, nb * 64, map_win(nb * 64), map_win(nb * 64 + 32), scr, F.lane); continue; }
        r -= I_IN;
        if (r < I_UQ) { const int kb = r / 24, nb = r % 24;
            xpose_item(a.in[I_WUQ] + (size_t)l * 512 * QW, QW, 512, lw(F.ws, l, LW_WUQ), a.in[I_QN] + l * 512, kb * 64, nb * 64, map_wuq(nb * 64), map_wuq(nb * 64 + 32), scr, F.lane); continue; }
        r -= I_UQ;
        if (r < I_UKV) { const int kb = r / 32, nb = r % 32;
            xpose_item(a.in[I_WUKV] + (size_t)l * 256 * KVW, KVW, 256, lw(F.ws, l, LW_WUKV), a.in[I_KVN] + l * 256, kb * 64, nb * 64, nb * 64, nb * 64 + 32, scr, F.lane); continue; }
        r -= I_UKV;
        if (r < I_SQ) { const int kb = r / 32, nb = r % 32;
            xpose_item(a.in[I_WOUT] + (size_t)l * DM * DM, DM, DM, lw(F.ws, l, LW_WOUT), nullptr, kb * 64, nb * 64, nb * 64, nb * 64 + 32, scr, F.lane); continue; }
        r -= I_SQ;
        if (r < I_KV) { const int kb = r / 64, nb = r % 64;
            xpose_item(a.in[I_XAWKV] + (size_t)l * DM * 4096, 4096, DM, (bf16_t*)(F.ws + WS_WKVT) + (size_t)l * 4096 * DM, a.in[I_MEMN] + l * DM, kb * 64, nb * 64, nb * 64, nb * 64 + 32, scr, F.lane); continue; }
        r -= I_KV;
        { const int kb = r / 32, nb = r % 32;
            xpose_item(a.in[I_XAWO] + (size_t)l * DM * DM, DM, DM, (bf16_t*)(F.ws + WS_WOT) + (size_t)l * DM * DM, nullptr, kb * 64, nb * 64, nb * 64, nb * 64 + 32, scr, F.lane); }
    }
    const size_t gt = (size_t)F.vcu * 512 + F.tid, NGT = (size_t)F.G * 512;
    for (size_t i = gt; i < (size_t)DEPTH * DM * DM / 8; i += NGT) { const size_t e = i * 8; const int l = (int)(e / ((size_t)DM * DM)), k = (int)((e / DM) % DM);
        const float g = a.in[I_XAN][l * DM + k]; const GAS f32x4* s = (const GAS f32x4*)(a.in[I_XAWQ] + e); const f32x4 v0 = s[0] * g, v1 = s[1] * g;
        *(GAS u32x4*)((bf16_t*)(F.ws + WS_WQG) + e) = pack8(v0, v1); }
    for (size_t i = gt; i < (size_t)DEPTH * 4 * 128 * 128 / 8; i += NGT) { const size_t e = i * 8; const int l = (int)(e >> 16), t = (int)((e >> 7) & 127), s0 = (int)(e & 127);
        const GAS f32x4* s = (const GAS f32x4*)(a.in[I_SGUW] + e); f32x4 v0 = s[0], v1 = s[1];
#pragma unroll
        for (int j = 0; j < 4; ++j) { if (s0 + j > t) v0[j] = 0.f; if (s0 + 4 + j > t) v1[j] = 0.f; }
        *(GAS u32x4*)(lw(F.ws, l, LW_WST) + (e & 65535)) = pack8(v0, v1); }
    for (size_t i = gt; i < (size_t)SEQ * 96; i += NGT) { const bool big = i < (size_t)SEQ * 64; const size_t j = big ? i : i - (size_t)SEQ * 64; const int half = big ? 64 : 32;
        const int pos = (int)(j / half), d = (int)(j % half); const float inv = exp2f(-(float)d * (2.0f / (float)(2 * half)) * 13.287712379549449f);
        const float ang = (float)pos * inv; double rev = (double)ang * 0.15915494309189535; rev -= floor(rev); const float fr = (float)rev;
        ((float*)(F.ws + (big ? TAB_C128 : TAB_C64)))[j] = __builtin_amdgcn_cosf(fr); ((float*)(F.ws + (big ? TAB_S128 : TAB_S64)))[j] = __builtin_amdgcn_sinf(fr); }
    { const int wr = F.wave >> 2, wc = F.wave & 3, fr = F.lane & 15, fq = F.lane >> 4;
      for (int u = F.vcu; u < 512; u += F.G) { const int pm = u >> 3, pn = u & 7; GAS unsigned* ep = (GAS unsigned*)(F.ws + WS_H) + ((size_t)(u * 8 + F.wave) * 64 + F.lane) * 8;
#pragma unroll 2
        for (int aim = 0; aim < 8; ++aim) { const int row = pm * 256 + wr * 64 + fr + 128 * (aim >> 2) + 16 * (aim & 3); float sq = 0.f; unsigned eo = 0u;
#pragma unroll
            for (int bj = 0; bj < 2; ++bj) { const size_t o = (size_t)row * DM + pn * 256 + wc * 32 + 8 * fq + 128 * bj; const f32x4 v0 = *(const GAS f32x4*)(a.in[I_X] + o), v1 = *(const GAS f32x4*)(a.in[I_X] + o + 4); u32x4 wout;
#pragma unroll
                for (int i = 0; i < 4; ++i) { const float h0 = i < 2 ? v0[2 * (i & 1)] : v1[2 * (i & 1)], h1 = i < 2 ? v0[2 * (i & 1) + 1] : v1[2 * (i & 1) + 1]; const unsigned nw = cvt_pk_bf16(h0, h1); wout[i] = nw;
                    eo |= ext_q(h0, nw << 16) << (2 * (8 * bj + 2 * i)); eo |= ext_q(h1, nw & 0xffff0000u) << (2 * (8 * bj + 2 * i + 1)); sq += h0 * h0 + h1 * h1; }
                *(GAS u32x4*)((bf16_t*)(F.ws + WS_HB) + o) = wout; }
            ep[aim] = eo; sq = quad_sum(sq); if (fq == 0) ((GAS float*)(F.ws + WS_SS))[(size_t)row * 32 + pn * 4 + wc] = sq; } } }
    for (int m = gw; m < MMEM; m += NGW) { const GAS f32x4* xr = (const GAS f32x4*)(a.in[I_MEM] + (size_t)m * DM) + 2 * F.lane; float s = 0.f; f32x4 v[8];
#pragma unroll
        for (int j = 0; j < 4; ++j) { v[2 * j] = xr[128 * j]; v[2 * j + 1] = xr[128 * j + 1]; s += dot4(v[2 * j]) + dot4(v[2 * j + 1]); }
        const float r = 1.0f / sqrtf(wave_sum(s) * (1.0f / DM) + EPS); GAS u32x4* br = (GAS u32x4*)((bf16_t*)(F.ws + WS_MEMN) + (size_t)m * DM) + F.lane;
#pragma unroll
        for (int j = 0; j < 4; ++j) br[64 * j] = pack8(v[2 * j] * r, v[2 * j + 1] * r); }
}

__device__ __forceinline__ void final_norm_phase(Frame& FF, const Args& a, const int panel, const int q, LAS float* rsw) {
    int tid_ = threadIdx.x; asm volatile("" : "+v"(tid_));
    const int lane = tid_ & 63, wave = __builtin_amdgcn_readfirstlane(tid_ >> 6), wr = wave >> 2, wc = wave & 3, fr = lane & 15, fq = lane >> 4;
    const int u0 = panel >= 0 ? panel * 8 + 2 * q : FF.vcu, u1 = panel >= 0 ? u0 + 2 : 512, ustep = panel >= 0 ? 1 : FF.G;
    for (int u = u0; u < u1; u += ustep) { const int pm = u >> 3, pn = u & 7;
        rstd_prep<32>((const float*)(FF.ws + WS_SS), pm, wr, lane, 1.0f / DM, rsw); float rs[2][4]; rstd_fetch(rsw, fr, rs);
        const GAS u32x4* ep = (const GAS u32x4*)((const GAS unsigned*)(FF.ws + WS_H) + ((size_t)(u * 8 + wave) * 64 + lane) * 8); const u32x4 ein[2] = {ep[0], ep[1]};
        EPI_ROWS { const int row = pm * 256 + wr * 64 + fr + 128 * ai + 16 * m; const float r = rs[ai][m]; const unsigned ew = ein[ai][m];
#pragma unroll
            for (int bj = 0; bj < 2; ++bj) { const int col = pn * 256 + wc * 32 + 8 * fq + 128 * bj; const size_t o = (size_t)row * DM + col; const u32x4 v = *(const GAS u32x4*)((const bf16_t*)(FF.ws + WS_HB) + o);
                const f32x4 g0 = *(const GAS f32x4*)(a.in[I_FIN] + col), g1 = *(const GAS f32x4*)(a.in[I_FIN] + col + 4); f32x4 o0, o1;
#define FN_PAIR(i, dst) { const unsigned w = v[i]; dst[2 * (i & 1)] = bj ? ext_join<8 + 2 * i>(w << 16, ew) : ext_join<2 * i>(w << 16, ew); dst[2 * (i & 1) + 1] = bj ? ext_join<9 + 2 * i>(w & 0xffff0000u, ew) : ext_join<1 + 2 * i>(w & 0xffff0000u, ew); }
                FN_PAIR(0, o0) FN_PAIR(1, o0) FN_PAIR(2, o1) FN_PAIR(3, o1)
#undef FN_PAIR
                *(GAS f32x4*)(a.out + o) = o0 * r * g0; *(GAS f32x4*)(a.out + o + 4) = o1 * r * g1; } }
        asm volatile("s_waitcnt lgkmcnt(0)" ::: "memory"); }
}
#define SBAR() __builtin_amdgcn_sched_barrier(0)
__device__ __forceinline__ int crow(int r, int hi) { return (r & 3) + 8 * (r >> 2) + 4 * hi; }
__device__ __forceinline__ int v_st(int k, int c) { const int kk = (k & ~0xC) | ((k & 4) << 1) | ((k & 8) >> 1); return ((kk >> 3) * 4 + (c >> 5)) * 512 + ((kk & 7) * 32 + (c & 31)) * 2; }
__device__ __forceinline__ int v_rd_base(int lane) { return ((lane & 3) << 3) | (((lane >> 2) & 3) << 6) | (((lane >> 4) & 1) << 5) | (((lane >> 5) & 1) << 8); }
constexpr int v_rd_off(int d0, int ks, int half) { return d0 * 512 + ks * 4096 + half * 2048; }
template <int OFF> __device__ __forceinline__ s16x4 tr_read(int vb) { s16x4 r; asm volatile("ds_read_b64_tr_b16 %0, %1 offset:%2" : "=&v"(r) : "v"(vb), "i"(OFF) : "memory"); return r; }
template <int D0> __device__ __forceinline__ void pv_one(f32x16& od, int vb, bf16x8 pa0, bf16x8 pa1, bf16x8 pa2, bf16x8 pa3) {
    const s16x4 l0 = tr_read<v_rd_off(D0, 0, 0)>(vb), h0 = tr_read<v_rd_off(D0, 0, 1)>(vb), l1 = tr_read<v_rd_off(D0, 1, 0)>(vb), h1 = tr_read<v_rd_off(D0, 1, 1)>(vb);
    const s16x4 l2 = tr_read<v_rd_off(D0, 2, 0)>(vb), h2 = tr_read<v_rd_off(D0, 2, 1)>(vb), l3 = tr_read<v_rd_off(D0, 3, 0)>(vb), h3 = tr_read<v_rd_off(D0, 3, 1)>(vb);
    asm volatile("s_waitcnt lgkmcnt(0)" ::: "memory"); SBAR();
#define PKV(L, H) (bf16x8){L[0], L[1], L[2], L[3], H[0], H[1], H[2], H[3]}
    od = __builtin_amdgcn_mfma_f32_32x32x16_bf16(PKV(l0, h0), pa0, od, 0, 0, 0);
    od = __builtin_amdgcn_mfma_f32_32x32x16_bf16(PKV(l1, h1), pa1, od, 0, 0, 0);
    od = __builtin_amdgcn_mfma_f32_32x32x16_bf16(PKV(l2, h2), pa2, od, 0, 0, 0);
    od = __builtin_amdgcn_mfma_f32_32x32x16_bf16(PKV(l3, h3), pa3, od, 0, 0, 0);
#undef PKV
}
template <int OFF> __device__ __forceinline__ bf16x8 lds_rd128(int addr) { bf16x8 r; asm volatile("ds_read_b128 %0, %1 offset:%2" : "=&v"(r) : "v"(addr), "i"(OFF) : "memory"); return r; }
template <int N> __device__ __forceinline__ void wait_lgkm() { asm volatile("s_waitcnt lgkmcnt(%0)" :: "n"(N) : "memory"); }
template <int D0, int NQ, int KPB> __device__ __forceinline__ void qk_steps(f32x16& p0, f32x16& p1, bf16x8 (&ka)[4], bf16x8 (&kc)[4], const bf16x8 (&qr)[NQ], const int kaddr) {
    if constexpr (D0 < NQ) {
        if constexpr (D0 + 3 < NQ) { ka[(D0 + 3) & 3] = lds_rd128<(D0 + 3) * 32>(kaddr); kc[(D0 + 3) & 3] = lds_rd128<(D0 + 3) * 32 + 32 * KPB>(kaddr); }
        constexpr int later = (D0 + 3 < NQ) ? 3 : NQ - 1 - D0;
        wait_lgkm<2 * later>(); SBAR();
        p0 = __builtin_amdgcn_mfma_f32_32x32x16_bf16(ka[D0 & 3], qr[D0], p0, 0, 0, 0); p1 = __builtin_amdgcn_mfma_f32_32x32x16_bf16(kc[D0 & 3], qr[D0], p1, 0, 0, 0);
        qk_steps<D0 + 1, NQ, KPB>(p0, p1, ka, kc, qr, kaddr);
    }
}
__device__ __forceinline__ float half_comb_sum(float x) { auto rr = __builtin_amdgcn_permlane32_swap(__float_as_uint(x), __float_as_uint(x), false, false); return __uint_as_float(rr[0]) + __uint_as_float(rr[1]); }
__device__ __forceinline__ float half_comb_max(float x) { auto rr = __builtin_amdgcn_permlane32_swap(__float_as_uint(x), __float_as_uint(x), false, false); return fmaxf(__uint_as_float(rr[0]), __uint_as_float(rr[1])); }
__device__ __forceinline__ void p_to_frags(const f32x16& p0, const f32x16& p1, bf16x8& pa0, bf16x8& pa1, bf16x8& pa2, bf16x8& pa3) {
#define PK4(P, BASE, OUT) do { unsigned a0 = cvt_pk_bf16(P[BASE + 0], P[BASE + 1]), a1 = cvt_pk_bf16(P[BASE + 2], P[BASE + 3]);   \
    unsigned b0 = cvt_pk_bf16(P[BASE + 4], P[BASE + 5]), b1 = cvt_pk_bf16(P[BASE + 6], P[BASE + 7]);                              \
    auto r0 = __builtin_amdgcn_permlane32_swap(a0, b0, false, false); auto r1 = __builtin_amdgcn_permlane32_swap(a1, b1, false, false); \
    u32x4 w = {r0[0], r1[0], r0[1], r1[1]}; OUT = __builtin_bit_cast(bf16x8, w); } while (0)
    PK4(p0, 0, pa0); PK4(p0, 8, pa1); PK4(p1, 0, pa2); PK4(p1, 8, pa3);
#undef PK4
}

struct AttnPtrs { const bf16_t* Q; int ldq; const bf16_t* K1; int ldk1; const bf16_t* K2; int ldk2; const bf16_t* V; int ldv; bf16_t* O; int ldo; const bf16_t* SG; int ldsg; const float* gn; float l2g; const bf16_t* PREV; };
template <int MODE>
__device__ __forceinline__ void attn_unit(LAS unsigned char* lds, const int qb, const AttnPtrs& T) {
    constexpr int DQK = MODE == 0 ? 192 : 128, NQ = DQK / 16, KCH = DQK / 8, KPB = DQK * 2 + 16  ,
                  KBYTES = 64 * KPB, NPIECE = KBYTES / 1024, KPT = (NPIECE + 7) / 8;
    static_assert(KBYTES % 1024 == 0, "K image is a whole number of 1 KiB LDS-DMA pieces");
    int tid = threadIdx.x; asm volatile("" : "+v"(tid));
    const int wid = __builtin_amdgcn_readfirstlane(tid >> 6), lane = tid & 63, r32 = lane & 31, hi = lane >> 5;
    constexpr int RING = MODE == 0 ? 3 : 2;
    LAS unsigned char* Kl = lds; LAS unsigned char* Vl = lds + RING * KBYTES;
    const int qmin = qb * 256 + wid * 32, qrow = qmin + r32;
    bf16x8 qr[NQ];
    { const bf16_t* qp = T.Q + (size_t)qrow * T.ldq + 8 * hi;
#pragma unroll
      for (int d0 = 0; d0 < NQ; ++d0) qr[d0] = *(const GAS bf16x8*)(qp + 16 * d0); }
    unsigned ksrc[KPT], vsrc[2];
#pragma unroll
    for (int i = 0; i < KPT; ++i) { const int p = (wid + 8 * i) * 1024 + lane * 16, row = (p / KPB) & 63, chp = (p % KPB) >> 4, ch = chp == KCH ? 0 : chp;
        ksrc[i] = (MODE == 0 && ch >= 16) ? (unsigned)(row * T.ldk2 + 8 * (ch - 16)) | 0x80000000u : (unsigned)(row * T.ldk1 + 8 * ch); }
#pragma unroll
    for (int i = 0; i < 2; ++i) { const int p = (wid * 2 + i) * 1024 + lane * 16, sub = p >> 9, within = (p & 511) >> 1, kk = ((sub >> 2) << 3) | (within >> 5), c = ((sub & 3) << 5) | (within & 31);
        const int k = (kk & ~0xC) | ((kk & 4) << 1) | ((kk & 8) >> 1); vsrc[i] = (unsigned)(k * T.ldv + c); }
    const int vb0 = (int)(unsigned)(uintptr_t)Vl + v_rd_base(lane);
#define A_STAGE(k0, b) do { _Pragma("unroll") for (int i = 0; i < KPT; ++i) if (wid + 8 * i < NPIECE) { \
        const bf16_t* src = (MODE == 0 && (ksrc[i] & 0x80000000u)) ? T.K2 + (size_t)(k0) * T.ldk2 + (ksrc[i] & 0x7fffffffu) : T.K1 + (size_t)(k0) * T.ldk1 + ksrc[i]; \
        __builtin_amdgcn_global_load_lds((const unsigned*)src, (LAS unsigned*)(Kl + (b) * KBYTES + (wid + 8 * i) * 1024), 16, 0, 0); } \
        _Pragma("unroll") for (int i = 0; i < 2; ++i) __builtin_amdgcn_global_load_lds((const unsigned*)(T.V + (size_t)(k0) * T.ldv + vsrc[i]), (LAS unsigned*)(Vl + (b) * 16384 + (wid * 2 + i) * 1024), 16, 0, 0); } while (0)
    f32x16 o[4];
#pragma unroll
    for (int d = 0; d < 4; ++d)
#pragma unroll
        for (int r = 0; r < 16; ++r) o[d][r] = 0.f;
    float m_reg = -1e30f, l_reg = 0.f;
    const int NT = 4 * (qb + 1), KT0 = MODE == 1 ? 4 * qb : 0;
    __syncthreads();
    if constexpr (MODE == 1) {
#pragma unroll
        for (int i = 0; i < 8; ++i) { const int piece = wid * 8 + i, tile = piece >> 4, p = (piece & 15) * 1024 + lane * 16, sub = p >> 9, within = (p & 511) >> 1, kk = ((sub >> 2) << 3) | (within >> 5), c = ((sub & 3) << 5) | (within & 31);
            const int k = (kk & ~0xC) | ((kk & 4) << 1) | ((kk & 8) >> 1);
            __builtin_amdgcn_global_load_lds((const unsigned*)(T.PREV + (size_t)(2 * qb + (tile >> 1)) * 16384 + (size_t)(64 * (tile & 1) + k) * 128 + c), (LAS unsigned*)(lds + 69632 + piece * 1024), 16, 0, 0); } }
    A_STAGE(64 * KT0, 0);
    if (RING == 3 && KT0 + 1 < NT) A_STAGE(64 * KT0 + 64, 1);
    int buf = 0;
    for (int kt = KT0; kt < NT; ++kt) {
        if (RING == 3 && kt + 1 < NT) { if (wid == 0) asm volatile("s_waitcnt vmcnt(6)" ::: "memory"); else asm volatile("s_waitcnt vmcnt(5)" ::: "memory"); }
        else asm volatile("s_waitcnt vmcnt(0)" ::: "memory");
        __syncthreads();
        const int k0 = 64 * kt, bprev = buf == 0 ? RING - 1 : buf - 1;
        if (RING == 3) { if (kt + 2 < NT) A_STAGE(k0 + 128, bprev); } else { if (kt + 1 < NT) A_STAGE(k0 + 64, buf ^ 1); }
        if (k0 <= qmin + 31 && (MODE == 0 || (k0 >> 7) == (qmin >> 7))) {
            f32x16 p0, p1;
#pragma unroll
            for (int r = 0; r < 16; ++r) { p0[r] = 0.f; p1[r] = 0.f; }
            { const int kaddr = (int)(unsigned)(uintptr_t)(Kl + buf * KBYTES + r32 * KPB) + (hi << 4); bf16x8 ka[4], kc[4];
#pragma unroll
              for (int i = 0; i < 3; ++i) { }
              ka[0] = lds_rd128<0>(kaddr); kc[0] = lds_rd128<32 * KPB>(kaddr); ka[1] = lds_rd128<32>(kaddr); kc[1] = lds_rd128<32 + 32 * KPB>(kaddr); ka[2] = lds_rd128<64>(kaddr); kc[2] = lds_rd128<64 + 32 * KPB>(kaddr);
              qk_steps<0, NQ, KPB>(p0, p1, ka, kc, qr, kaddr); }
            const bool diag = k0 + 63 > qmin;
            if constexpr (MODE == 0) {
                if (diag) {
#pragma unroll
                    for (int r = 0; r < 16; ++r) { const int key = k0 + crow(r, hi); if (key > qrow) p0[r] = -1e30f; if (key + 32 > qrow) p1[r] = -1e30f; } }
                float pmax = p0[0];
#pragma unroll
                for (int r = 1; r < 16; ++r) pmax = fmaxf(pmax, p0[r]);
#pragma unroll
                for (int r = 0; r < 16; ++r) pmax = fmaxf(pmax, p1[r]);
                pmax = half_comb_max(pmax);
                const float mn = fmaxf(m_reg, pmax), alpha = __builtin_amdgcn_exp2f(m_reg - mn); m_reg = mn;
                float ps = 0.f;
#pragma unroll
                for (int r = 0; r < 16; ++r) { p0[r] = __builtin_amdgcn_exp2f(p0[r] - mn); p1[r] = __builtin_amdgcn_exp2f(p1[r] - mn); ps += p0[r] + p1[r]; }
                ps = half_comb_sum(ps); l_reg = l_reg * alpha + ps;
                if (__any(alpha < 1.0f)) {
#pragma unroll
                    for (int d = 0; d < 4; ++d)
#pragma unroll
                        for (int r = 0; r < 16; ++r) o[d][r] *= alpha; }
            } else {
                const float cf = exp2f(-127.0f * T.l2g);
#pragma unroll
                for (int r = 0; r < 16; ++r) { p0[r] *= cf; p1[r] *= cf; }
                if (diag) {
#pragma unroll
                    for (int r = 0; r < 16; ++r) { const int key = k0 + crow(r, hi); if (key > qrow) p0[r] = 0.f; if (key + 32 > qrow) p1[r] = 0.f; } }
            }
            bf16x8 pa0, pa1, pa2, pa3; p_to_frags(p0, p1, pa0, pa1, pa2, pa3);
            const int vb = vb0 + buf * 16384;
            pv_one<0>(o[0], vb, pa0, pa1, pa2, pa3); pv_one<1>(o[1], vb, pa0, pa1, pa2, pa3); pv_one<2>(o[2], vb, pa0, pa1, pa2, pa3); pv_one<3>(o[3], vb, pa0, pa1, pa2, pa3);
        }
        buf = buf == RING - 1 ? 0 : buf + 1;
    }
#undef A_STAGE
    if constexpr (MODE == 1) {
        if ((qmin >> 7) > 0) { const int vbp = (int)(unsigned)(uintptr_t)(lds + 69632) + ((wid >> 2) * 32768) + v_rd_base(lane);
            pv_one<0>(o[0], vbp, qr[0], qr[1], qr[2], qr[3]); pv_one<1>(o[1], vbp, qr[0], qr[1], qr[2], qr[3]); pv_one<2>(o[2], vbp, qr[0], qr[1], qr[2], qr[3]); pv_one<3>(o[3], vbp, qr[0], qr[1], qr[2], qr[3]);
            pv_one<0>(o[0], vbp + 16384, qr[4], qr[5], qr[6], qr[7]); pv_one<1>(o[1], vbp + 16384, qr[4], qr[5], qr[6], qr[7]); pv_one<2>(o[2], vbp + 16384, qr[4], qr[5], qr[6], qr[7]); pv_one<3>(o[3], vbp + 16384, qr[4], qr[5], qr[6], qr[7]); } }
    if constexpr (MODE == 0) {
        const float inv = fast_rcp(l_reg); bf16_t* op = T.O + (size_t)qrow * T.ldo + 8 * hi;
#pragma unroll
        for (int d0 = 0; d0 < 4; ++d0)
#pragma unroll
            for (int g = 0; g < 4; g += 2) { const unsigned ax = cvt_pk_bf16_c(o[d0][4 * g] * inv, o[d0][4 * g + 1] * inv), ay = cvt_pk_bf16_c(o[d0][4 * g + 2] * inv, o[d0][4 * g + 3] * inv);
                const unsigned bx = cvt_pk_bf16_c(o[d0][4 * g + 4] * inv, o[d0][4 * g + 5] * inv), by = cvt_pk_bf16_c(o[d0][4 * g + 6] * inv, o[d0][4 * g + 7] * inv);
                const auto rx = __builtin_amdgcn_permlane32_swap(ax, bx, false, false), ry = __builtin_amdgcn_permlane32_swap(ay, by, false, false);
                *(GAS u32x4*)(op + 32 * d0 + 8 * g) = (u32x4){rx[0], ry[0], rx[1], ry[1]}; }
    } else {
        float s = 0.f;
#pragma unroll
        for (int d = 0; d < 4; ++d)
#pragma unroll
            for (int r = 0; r < 16; ++r) s += o[d][r];
        const float mu = half_comb_sum(s) * (1.0f / 128.0f); float q = 0.f;
#pragma unroll
        for (int d = 0; d < 4; ++d)
#pragma unroll
            for (int r = 0; r < 16; ++r) { const float t = o[d][r] - mu; q += t * t; }
        const float rstd = 1.0f / sqrtf(half_comb_sum(q) * (1.0f / 128.0f) + EPS);
        bf16_t* op = T.O + (size_t)qrow * T.ldo + 8 * hi; const bf16_t* gp = T.SG + (size_t)qrow * T.ldsg + 4 * hi; const float* np = T.gn + 4 * hi;
#pragma unroll
        for (int d0 = 0; d0 < 4; ++d0)
#pragma unroll
            for (int g = 0; g < 4; g += 2) { unsigned wx[2], wy[2];
#pragma unroll
                for (int j = 0; j < 2; ++j) { const int gg = g + j; const u32x2 sg = *(const GAS u32x2*)(gp + 32 * d0 + 8 * gg); const f32x4 gv = *(const GAS f32x4*)(np + 32 * d0 + 8 * gg);
                    const float y0 = (o[d0][4 * gg] - mu) * rstd * gv[0] * bf_lo(sg.x), y1 = (o[d0][4 * gg + 1] - mu) * rstd * gv[1] * bf_hi(sg.x);
                    const float y2 = (o[d0][4 * gg + 2] - mu) * rstd * gv[2] * bf_lo(sg.y), y3 = (o[d0][4 * gg + 3] - mu) * rstd * gv[3] * bf_hi(sg.y);
                    wx[j] = cvt_pk_bf16_c(y0, y1); wy[j] = cvt_pk_bf16_c(y2, y3); }
                const auto rx = __builtin_amdgcn_permlane32_swap(wx[0], wx[1], false, false), ry = __builtin_amdgcn_permlane32_swap(wy[0], wy[1], false, false);
                *(GAS u32x4*)(op + 32 * d0 + 8 * g) = (u32x4){rx[0], ry[0], rx[1], ry[1]}; }
    }
}

__device__ __forceinline__ void sgu_unit(LAS unsigned char* lds, const bf16_t* proj  , const float* ssv  , const bf16_t* wst  , const float* gain  ,
                                         const float* bias  , bf16_t* yc  , const int g) {
    int tid = threadIdx.x; asm volatile("" : "+v"(tid));
    const int wid = __builtin_amdgcn_readfirstlane(tid >> 6), lane = tid & 63, r32 = lane & 31, hi = lane >> 5, rb = wid & 3, ch = wid >> 2;
    LAS unsigned char* Vl = lds;
    __syncthreads();
    { const int sr = tid >> 4, sc = (tid & 15) * 8; const f32x4 g0 = *(const GAS f32x4*)(gain + sc), g1 = *(const GAS f32x4*)(gain + sc + 4);
#pragma unroll
      for (int i = 0; i < 4; ++i) { const int s = sr + 32 * i; const GAS f32x4* sp = (const GAS f32x4*)(ssv + (size_t)s * 8); const f32x4 a = sp[0], b2 = sp[1];
          const float rs = __builtin_amdgcn_rsqf((((a[0] + a[1]) + (a[2] + a[3])) + ((b2[0] + b2[1]) + (b2[2] + b2[3]))) * (1.0f / 512.0f) + EPS);
          const u32x4 v = *(const GAS u32x4*)(proj + (size_t)s * INP + 512 + 128 * g + sc);
          f32x4 x0 = {bf_lo(v.x), bf_hi(v.x), bf_lo(v.y), bf_hi(v.y)}, x1 = {bf_lo(v.z), bf_hi(v.z), bf_lo(v.w), bf_hi(v.w)};
          x0 = x0 * g0 * rs; x1 = x1 * g1 * rs;
          *(LAS u32x4*)(Vl + (s >> 6) * 16384 + v_st(s & 63, sc)) = pack8(x0, x1); } }
    bf16x8 pa[8];
    { const bf16_t* wp = wst + (size_t)(32 * rb + r32) * 128 + 8 * hi;
#pragma unroll
      for (int ks = 0; ks < 8; ++ks) pa[ks] = *(const GAS bf16x8*)(wp + 16 * ks); }
    __syncthreads();
    f32x16 o[2];
#pragma unroll
    for (int d = 0; d < 2; ++d)
#pragma unroll
        for (int r = 0; r < 16; ++r) o[d][r] = 0.f;
    const int vb = (int)(unsigned)(uintptr_t)Vl + v_rd_base(lane) + (2 * ch) * 512;
    pv_one<0>(o[0], vb, pa[0], pa[1], pa[2], pa[3]); pv_one<1>(o[1], vb, pa[0], pa[1], pa[2], pa[3]);
    pv_one<0>(o[0], vb + 16384, pa[4], pa[5], pa[6], pa[7]); pv_one<1>(o[1], vb + 16384, pa[4], pa[5], pa[6], pa[7]);
    const int t = 32 * rb + r32; const float bt = bias[t];
    const bf16_t* up = proj + (size_t)t * INP + 128 * g + 64 * ch + 4 * hi; bf16_t* op = yc + (size_t)t * DM + 64 * ch + 4 * hi;
#pragma unroll
    for (int d0 = 0; d0 < 2; ++d0)
#pragma unroll
        for (int q = 0; q < 4; ++q) { const u32x2 uu = *(const GAS u32x2*)(up + 32 * d0 + 8 * q);
            u32x2 w; w.x = cvt_pk_bf16(bf_lo(uu.x) * (o[d0][4 * q] + bt), bf_hi(uu.x) * (o[d0][4 * q + 1] + bt)); w.y = cvt_pk_bf16(bf_lo(uu.y) * (o[d0][4 * q + 2] + bt), bf_hi(uu.y) * (o[d0][4 * q + 3] + bt));
            *(GAS u32x2*)(op + 32 * d0 + 8 * q) = w; }
}

__device__ __forceinline__ void kvstate_unit(LAS unsigned char* lds, const bf16_t* Kp, const bf16_t* Vp  , float* out) {
    int tid = threadIdx.x; asm volatile("" : "+v"(tid));
    const int wid = __builtin_amdgcn_readfirstlane(tid >> 6), lane = tid & 63, r32 = lane & 31, hi = lane >> 5;
    __syncthreads();
#pragma unroll
    for (int i = 0; i < 8; ++i) { const int piece = wid * 8 + i, tile = piece >> 4, p = (piece & 15) * 1024 + lane * 16, sub = p >> 9, within = (p & 511) >> 1, kk = ((sub >> 2) << 3) | (within >> 5), c = ((sub & 3) << 5) | (within & 31);
        const int k = (kk & ~0xC) | ((kk & 4) << 1) | ((kk & 8) >> 1); const bf16_t* src = ((tile & 2) ? Vp : Kp) + (size_t)(64 * (tile & 1) + k) * INP + c;
        __builtin_amdgcn_global_load_lds((const unsigned*)src, (LAS unsigned*)(lds + piece * 1024), 16, 0, 0); }
    asm volatile("s_waitcnt vmcnt(0)" ::: "memory");
    __syncthreads();
    const int D0 = wid & 3, E0 = 2 * (wid >> 2); const int kb = (int)(unsigned)(uintptr_t)lds + v_rd_base(lane) + D0 * 512, vb = (int)(unsigned)(uintptr_t)(lds + 32768) + v_rd_base(lane) + E0 * 512;
    f32x16 a0, a1;
#pragma unroll
    for (int r = 0; r < 16; ++r) { a0[r] = 0.f; a1[r] = 0.f; }
#define PKV(L, H) (bf16x8){L[0], L[1], L[2], L[3], H[0], H[1], H[2], H[3]}
#define KV_STEP(T_, KS) do { const s16x4 kl = tr_read<v_rd_off(0, KS, 0)>(kb + T_ * 16384), kh = tr_read<v_rd_off(0, KS, 1)>(kb + T_ * 16384); \
        const s16x4 ul = tr_read<v_rd_off(0, KS, 0)>(vb + T_ * 16384), uh = tr_read<v_rd_off(0, KS, 1)>(vb + T_ * 16384), wl = tr_read<v_rd_off(1, KS, 0)>(vb + T_ * 16384), wh = tr_read<v_rd_off(1, KS, 1)>(vb + T_ * 16384); \
        asm volatile("s_waitcnt lgkmcnt(0)" ::: "memory"); SBAR(); \
        a0 = __builtin_amdgcn_mfma_f32_32x32x16_bf16(PKV(kl, kh), PKV(ul, uh), a0, 0, 0, 0); a1 = __builtin_amdgcn_mfma_f32_32x32x16_bf16(PKV(kl, kh), PKV(wl, wh), a1, 0, 0, 0); } while (0)
    KV_STEP(0, 0); KV_STEP(0, 1); KV_STEP(0, 2); KV_STEP(0, 3); KV_STEP(1, 0); KV_STEP(1, 1); KV_STEP(1, 2); KV_STEP(1, 3);
#undef KV_STEP
#undef PKV
    GAS float* op = (GAS float*)out + (size_t)(32 * D0 + 4 * hi) * 128 + 32 * E0 + r32;
#pragma unroll
    for (int r = 0; r < 16; ++r) { const int ro = ((r & 3) + 8 * (r >> 2)) * 128; op[ro] = a0[r]; op[ro + 32] = a1[r]; }
}
__device__ __forceinline__ void retention_scan(const float* kvs, bf16_t* prev, int gtid  ) {
    const int bh = gtid >> 13, de = (gtid & 8191) * 2, h = bh & 3; const float l2g = log2f(1.0f - exp2f(-5.0f - (float)h)), gam = exp2f(l2g), g128 = exp2f(128.0f * l2g);
    const GAS f32x2* s = (const GAS f32x2*)(kvs + (size_t)bh * 32 * 16384 + de); GAS unsigned* p = (GAS unsigned*)(prev + (size_t)bh * 32 * 16384 + de);
    float s0 = 0.f, s1 = 0.f;
#pragma unroll 8
    for (int n = 0; n < 32; ++n) { p[(size_t)n * 8192] = cvt_pk_bf16(gam * s0, gam * s1); const f32x2 v = s[(size_t)n * 8192]; s0 = g128 * s0 + v[0]; s1 = g128 * s1 + v[1]; }
}
struct SchedKvm : pg8::Sched {
    __device__ bool next(int i, Unit& u) const { if (!pg8::Sched::next(i, u)) return false; u.coff = (size_t)(u.pn >> 4) * ((size_t)MMEM * 4096 - 4096); return true; }
};
struct SchedAT {
    int G, c; unsigned char* ws;
    __device__ bool next(int i, Unit& u) const { const int L = i * G + c; if (L >= 512) return false; const int lbh = L >> 3, pn = L & 7, l = lbh >> 4, b = (lbh >> 2) & 3, h = lbh & 3;
        u.pm = 0; u.pn = pn;
        u.A = (const char*)(ws + WS_KVM) + ((size_t)l * MMEM * 4096 + (size_t)(b * 256) * 4096 + 512 * h) * 2;
        u.B = (const char*)(ws + WS_WQG) + ((size_t)l * DM * DM + (size_t)(256 * pn) * DM + 512 * h) * 2;
        u.coff = (size_t)l * (LW_STRIDE / 2) + (size_t)b * 1024 * DM + (size_t)(256 * h) * DM; return true; }
};
struct SchedCT {
    int G, c; unsigned char* ws;
    __device__ bool next(int i, Unit& u) const { const int L = i * G + c; if (L >= 512) return false; const int lbh = L >> 3, pm = L & 7, l = lbh >> 4, b = (lbh >> 2) & 3, h = lbh & 3;
        u.pm = pm; u.pn = 0;
        u.A = (const char*)(ws + WS_WOT) + ((size_t)l * DM * DM + (size_t)(256 * pm) * DM + 512 * h) * 2;
        u.B = (const char*)(ws + WS_KVM) + ((size_t)l * MMEM * 4096 + (size_t)(b * 256) * 4096 + 2048 + 512 * h) * 2;
        u.coff = (size_t)l * (LW_STRIDE / 2) + (size_t)b * DM * 1024 + 256 * h; return true; }
};

constexpr int NPRO = 3, NLP = 10, PH_FINAL = NPRO + DEPTH * NLP, NPHASE = PH_FINAL + 1;
__global__ void __launch_bounds__(512, 2) fwd_kernel(Args args) {
    extern __shared__ __attribute__((aligned(16))) unsigned char lds_raw[];
    Frame F;
    F.lds = (LAS unsigned char*)lds_raw;
    F.MISC = (volatile LAS unsigned*)(F.lds + MISC_OFF);
    F.tid = threadIdx.x; F.lane = F.tid & 63; F.wave = __builtin_amdgcn_readfirstlane(F.tid >> 6);
    F.G = gridDim.x; { const int bx = blockIdx.x; F.vcu = (F.G % 8 == 0) ? (bx % 8) * (F.G / 8) + bx / 8 : bx; }
    F.ws = args.ws; F.ctl = (unsigned*)(args.ws + WS_CTL);
    unsigned char* ws = args.ws;
    if (F.tid < 32) F.MISC[F.tid] = 0u;
    __syncthreads();
    const int lo = args.ph_lo, hi = args.ph_hi;
    XcdBarrier bar; bar.bar = F.ctl + CW_BAR; bar.x = 0; bar.st = nullptr;
    if (hi - lo > 1) bar = xcd_barrier_post(F.ctl + CW_BAR, F.MISC + 8);
#ifndef PH_MASK
#define PH_MASK 0xFFFF
#endif
#define PHON(id) (((PH_MASK) >> (id)) & 1)
#ifndef REP_MASK
#define REP_MASK 0
#endif
#define NREP(id) (1 + (((REP_MASK) >> (id)) & 1))
#define IN(k) (lo <= (k) && (k) < hi)
#define SEAM(k) do { if (IN(k) && IN((k) + 1)) xcd_barrier(bar); } while (0)
    const int cid = (int)blockIdx.x;
    LAS float* const RSW = (LAS float*)(F.lds + RSW_OFF) + F.wave * 128;
    if (PHON(10) && IN(0)) { for (int rep = 0; rep < NREP(10); ++rep) p0_prologue(F, args); } SEAM(0);
    if (PHON(11) && IN(1)) for (int rep = 0; rep < NREP(11); ++rep) { SchedKvm S; S.init(MMEM, DEPTH * 4096, F.G, cid, ws + WS_MEMN, DM, ws + WS_WKVT, DM);
        EpiPlain E{(bf16_t*)(ws + WS_KVM), 4096}; pg8::gemm_phase<EpiPlain, SchedKvm>(F.lds + RING_OFF, DM, DM, DM, S, E); } SEAM(1);
    if (PHON(12) && IN(2)) for (int rep = 0; rep < NREP(12); ++rep) { { SchedAT S{F.G, cid, ws}; EpiPlain E{(bf16_t*)(ws + WS_LW + LW_BTS), DM}; pg8::gemm_phase<EpiPlain, SchedAT>(F.lds + RING_OFF, 512, 4096, DM, S, E); }
                 { SchedCT S{F.G, cid, ws}; EpiPlain E{(bf16_t*)(ws + WS_LW + LW_BTO), 1024}; pg8::gemm_phase<EpiPlain, SchedCT>(F.lds + RING_OFF, 512, DM, 4096, S, E); } } SEAM(2);

    bool local_ok = false; int cidl = (int)blockIdx.x;
    if (hi - lo == NPHASE) {
        if (F.tid == 0) { bool ok = F.G == 256; for (unsigned j = 0; j < 16; ++j) { const unsigned c = xb_ld(&bar.bar[XB_XCNT(j)]); ok = ok && (j < 8 ? c == 32u : c == 0u); } F.MISC[11] = ok ? 1u : 0u; }
        __syncthreads();
        local_ok = __builtin_amdgcn_readfirstlane((int)F.MISC[11]) != 0; if (local_ok) cidl = __builtin_amdgcn_readfirstlane((int)F.MISC[10] * 8 + (int)bar.x);
    }
#ifndef LOCAL_BAR_ON
#define LOCAL_BAR_ON 1
#endif
#define SEAM_L(k) do { if (IN(k) && IN((k) + 1)) { if (local_ok && LOCAL_BAR_ON) xcc_local_barrier(bar.bar, 8u * bar.x + (unsigned)((cidl >> 3) & 7), 4u); else xcd_barrier(bar); } } while (0)
#define SEAM_P(k) do { if (IN(k) && IN((k) + 1)) { if (local_ok && LOCAL_BAR_ON) xcd_barrier(bar, XB_TOP2(bar.x >> 1), XB_TOPGEN2(bar.x >> 1), 2u); else xcd_barrier(bar); } } while (0)
#pragma clang loop unroll(disable)
    for (int l = 0; l < DEPTH; ++l) {
        const int pb = NPRO + NLP * l; int cid = cidl;
        asm volatile("" : "+s"(ws));
        asm volatile("" : "+s"(cid));
        unsigned* const HLp = (unsigned*)(ws + WS_H); bf16_t* const HBp = (bf16_t*)(ws + WS_HB); float* const SSp = (float*)(ws + WS_SS);
        bf16_t* const ACTp = (bf16_t*)(ws + WS_ACT); bf16_t* const PROJp = (bf16_t*)(ws + WS_PROJ); bf16_t* const QMp = (bf16_t*)(ws + WS_QM);
        bf16_t* const KNp = (bf16_t*)(ws + WS_KN); bf16_t* const VVp = (bf16_t*)(ws + WS_VV); bf16_t* const YCp = (bf16_t*)(ws + WS_YC); bf16_t* const PXp = (bf16_t*)(ws + WS_PX);
        float* const SSVp = (float*)(ws + WS_SSV); float* const SSQp = (float*)(ws + WS_SSQ); float* const SSKp = (float*)(ws + WS_SSK);
        const float* const C128 = (const float*)(ws + TAB_C128); const float* const S128 = (const float*)(ws + TAB_S128); const float* const C64 = (const float*)(ws + TAB_C64); const float* const S64 = (const float*)(ws + TAB_S64);

        if (PHON(0) && IN(pb + 0)) for (int rep = 0; rep < NREP(0); ++rep) { pg8::Sched S; S.init(MTOK, NGU, F.G, cid, HBp, DM, lw(ws, l, LW_W1), DM); EpiGlu E{RSW, ACTp, SSp}; pg8::gemm_phase<EpiGlu, pg8::Sched>(F.lds + RING_OFF, DM, DM, DM, S, E); } SEAM_L(pb + 0);
        if (PHON(1) && IN(pb + 1)) for (int rep = 0; rep < NREP(1); ++rep) { pg8::Sched S; S.init(MTOK, DM, F.G, cid, ACTp, DFF, lw(ws, l, LW_W2), DFF); EpiRes E{HBp, HLp, SSp, rep ? 0.0f : 0.5f}; pg8::gemm_phase<EpiRes, pg8::Sched>(F.lds + RING_OFF, DFF, DFF, DFF, S, E); } SEAM_L(pb + 1);
        if (PHON(2) && IN(pb + 2)) for (int rep = 0; rep < NREP(2); ++rep) { pg8::Sched S; S.init(MTOK, INP, F.G, cid, HBp, DM, lw(ws, l, LW_WIN), DM); EpiMix E{RSW, PROJp, SSp, SSVp, SSQp, SSKp, C128, S128, C64, S64};
            pg8::gemm_phase<EpiMix, pg8::Sched>(F.lds + RING_OFF, DM, DM, DM, S, E); } SEAM_L(pb + 2);
        if (IN(pb + 3)) for (int rep = 0; rep < NREP(3); ++rep) {
            if (PHON(3)) { pg8::Sched S; S.init(MTOK, QW, F.G, cid, PROJp + 3072, INP, lw(ws, l, LW_WUQ), 512); EpiQ E{RSW, QMp, SSQp, C64, S64}; pg8::gemm_phase<EpiQ, pg8::Sched>(F.lds + RING_OFF, 512, INP, 512, S, E); }
            if (PHON(8)) { pg8::Sched S; S.init(MTOK, KVW, F.G, cid, PROJp + 3584, INP, lw(ws, l, LW_WUKV), 256); EpiKV E{RSW, KNp, SSKp}; pg8::gemm_phase<EpiKV, pg8::Sched>(F.lds + RING_OFF, 256, INP, 256, S, E); }
            for (int w = (F.G == 256 ? 0 : cid); w < (F.G == 256 ? 1 : 512); w += F.G) {
            const int q = (cid >> 3) >> 3, u0 = F.G == 256 ? (q < 2 ? q : 3 * q - 4) : (w & 7), u1 = F.G == 256 ? (q < 2 ? q + 1 : 3 * q - 1) : (w & 7) + 1, pan = F.G == 256 ? 8 * (cid & 7) + ((cid >> 3) & 7) : (w >> 3);
            if (PHON(9)) for (int u = u0; u < u1; ++u) { const int g = u & 3, bn = 2 * pan + (u >> 2); const size_t t0 = (size_t)bn * 128;
                sgu_unit(F.lds + RING_OFF, PROJp + t0 * INP, SSVp + t0 * 8, lw(ws, l, LW_WST) + g * 16384, args.in[I_SGUN] + l * 512 + 128 * g, args.in[I_SGUB] + l * 512 + 128 * g, YCp + t0 * DM + 128 * g, g); }
            if (PHON(9)) for (int u = u0; u < u1; ++u) { const int h = u & 3, bn = 2 * pan + (u >> 2), b = bn >> 5, n = bn & 31; const bf16_t* pr = PROJp + (size_t)bn * 128 * INP + 128 * h;
                kvstate_unit(F.lds + RING_OFF, pr + 1536, pr + 2048, (float*)(ws + WS_KVS) + (size_t)((b * 4 + h) * 32 + n) * 16384); } }
        } SEAM_P(pb + 3);
        if (PHON(4) && IN(pb + 4)) for (int rep = 0; rep < NREP(4); ++rep) {
            const bool pairq = local_ok && LOCAL_BAR_ON; const int bq0 = pairq ? (cid & 7) >> 1 : (int)(((long)cid * 4) / F.G);
            for (int kq = 0; kq < (pairq ? 1 : 4); ++kq) { const int bq = (bq0 + kq) & 3;
            unsigned* head = F.ctl + CW_QUEUE + 64 * ((l + 4 * rep) * 4 + bq);
            for (;;) {
                __syncthreads();
                if (F.tid == 0) F.MISC[0] = __hip_atomic_fetch_add(head, 1u, RLX_AGENT);
                __syncthreads();
                const int qi = (int)F.MISC[0];
                if (qi >= 16 + 192) break;
                unsigned* sflag = F.ctl + CW_QUEUE + 64 * (32 + l * 4 + bq);
                if (qi < 16) {
                    int t_ = threadIdx.x; asm volatile("" : "+v"(t_));
                    for (int q = 0; q < 4; ++q) retention_scan((const float*)(ws + WS_KVS), (bf16_t*)(ws + WS_PREV), (16 * bq + qi) * 2048 + q * 512 + t_);
                    asm volatile("s_waitcnt vmcnt(0)" ::: "memory"); __syncthreads();
                    if (F.tid == 0) { __builtin_amdgcn_fence(__ATOMIC_RELEASE, "agent"); asm volatile("s_waitcnt vmcnt(0)" ::: "memory"); (void)__hip_atomic_fetch_add(sflag, 1u, RLX_AGENT); }
                    continue; }
                const int idx = qi - 16, b = bq;
                if (idx < 128) { const int qb = 15 - (idx >> 3), h = idx & 7; const size_t row0 = (size_t)b * SEQ;
                    AttnPtrs T{QMp + row0 * QW + 192 * h, QW, KNp + row0 * 1024 + 128 * h, 1024, PROJp + row0 * INP + 3840, INP, VVp + row0 * 1024 + 128 * h, 1024, YCp + row0 * DM + 1024 + 128 * h, DM, nullptr, 0, nullptr, 0.f, nullptr};
                    attn_unit<0>(F.lds + RING_OFF, qb, T);
                } else { const int j = idx - 128, qb = j >> 2, h = j & 3; const size_t row0 = (size_t)b * SEQ; const bf16_t* pr = PROJp + row0 * INP + 128 * h;
                    if (F.tid == 0) { unsigned sp = 0; while (__hip_atomic_load(sflag, RLX_AGENT) < 16u) { __builtin_amdgcn_s_sleep(2); if (++sp > (1u << 22)) break; }
                        __builtin_amdgcn_fence(__ATOMIC_ACQUIRE, "agent"); asm volatile("s_waitcnt vmcnt(0)" ::: "memory"); }
                    __syncthreads();
                    AttnPtrs T{pr + 1024, INP, pr + 1536, INP, nullptr, 0, pr + 2048, INP, YCp + row0 * DM + 512 + 128 * h, DM, pr + 2560, INP, args.in[I_RETGN] + l * 512 + 128 * h, log2f(1.0f - exp2f(-5.0f - (float)h)), (const bf16_t*)(ws + WS_PREV) + (size_t)(b * 4 + h) * 32 * 16384};
                    attn_unit<1>(F.lds + RING_OFF, qb, T); }
            } }
        } SEAM_P(pb + 4);
        if (PHON(5) && IN(pb + 5)) for (int rep = 0; rep < NREP(5); ++rep) { pg8::Sched S; S.init(MTOK, DM, F.G, cid, YCp, DM, lw(ws, l, LW_WOUT), DM); EpiRes E{HBp, HLp, SSp, rep ? 0.0f : 1.0f}; pg8::gemm_phase<EpiRes, pg8::Sched>(F.lds + RING_OFF, DM, DM, DM, S, E); } SEAM_L(pb + 5);
        if (PHON(6) && IN(pb + 6)) for (int rep = 0; rep < NREP(6); ++rep) { pg8::Sched S; S.init(MTOK, 1024, F.G, cid, HBp, DM, lw(ws, l, LW_BTS), DM); S.bshift = 4; S.bbatch = (size_t)1024 * DM * 2; EpiSm E{RSW, PXp, SSp, (LAS float*)(F.lds + XL_OFF)};
            pg8::gemm_phase<EpiSm, pg8::Sched>(F.lds + RING_OFF, DM, DM, DM, S, E); } SEAM_L(pb + 6);
        if (PHON(7) && IN(pb + 7)) for (int rep = 0; rep < NREP(7); ++rep) { pg8::Sched S; S.init(MTOK, DM, F.G, cid, PXp, 1024, lw(ws, l, LW_BTO), 1024); S.bshift = 4; S.bbatch = (size_t)DM * 1024 * 2; EpiRes E{HBp, HLp, SSp, rep ? 0.0f : 1.0f};
            pg8::gemm_phase<EpiRes, pg8::Sched>(F.lds + RING_OFF, 1024, 1024, 1024, S, E); } SEAM_L(pb + 7);
        if (PHON(8) && IN(pb + 8)) for (int rep = 0; rep < NREP(8); ++rep) { pg8::Sched S; S.init(MTOK, NGU, F.G, cid, HBp, DM, lw(ws, l, LW_W7), DM); EpiGlu E{RSW, ACTp, SSp}; pg8::gemm_phase<EpiGlu, pg8::Sched>(F.lds + RING_OFF, DM, DM, DM, S, E); } SEAM_L(pb + 8);
        if (PHON(9) && IN(pb + 9)) for (int rep = 0; rep < NREP(9); ++rep) { pg8::Sched S; S.init(MTOK, DM, F.G, cid, ACTp, DFF, lw(ws, l, LW_W8), DFF); EpiRes E{HBp, HLp, SSp, rep ? 0.0f : 0.5f}; pg8::gemm_phase<EpiRes, pg8::Sched>(F.lds + RING_OFF, DFF, DFF, DFF, S, E); } SEAM_L(pb + 9);
    }
    if (PHON(13) && IN(PH_FINAL)) { if (local_ok && LOCAL_BAR_ON) final_norm_phase(F, args, 8 * (cidl & 7) + ((cidl >> 3) & 7), cidl >> 6, RSW); else final_norm_phase(F, args, -1, 0, RSW); }
#undef IN
#undef SEAM
}

#ifndef MK_SPLIT
#define MK_SPLIT 0
#endif
extern "C" void kernel_launch(void* const* d_in, const int* in_sizes, int n_in, void* d_out, int out_size, void* d_ws, size_t ws_size, hipStream_t stream) {
    static int grid = 0;
    if (grid == 0) {
        if (n_in != 27 || in_sizes[0] != MTOK * DM || out_size != MTOK * DM || ws_size < WS_END) { fprintf(stderr, "kernel_launch: unexpected shapes (n_in %d, in0 %d, out %d, ws %zu < %zu)\n", n_in, n_in > 0 ? in_sizes[0] : -1, out_size, ws_size, (size_t)WS_END); grid = -1; return; }
        int dev = 0, cus = 0, per_cu = 0;
        if (hipGetDevice(&dev) != hipSuccess || hipDeviceGetAttribute(&cus, hipDeviceAttributeMultiprocessorCount, dev) != hipSuccess) { grid = -1; return; }
        if (hipFuncSetAttribute((const void*)fwd_kernel, hipFuncAttributeMaxDynamicSharedMemorySize, LDS_BYTES) != hipSuccess) { fprintf(stderr, "kernel_launch: hipFuncSetAttribute failed\n"); grid = -1; return; }
        if (hipOccupancyMaxActiveBlocksPerMultiprocessor(&per_cu, (const void*)fwd_kernel, 512, LDS_BYTES) != hipSuccess || per_cu < 1) fprintf(stderr, "kernel_launch: occupancy query reports %d\n", per_cu);
        (void)hipGetLastError();
        grid = cus;
    }
    if (grid < 0) return;
    if (hipMemsetAsync((char*)d_ws + WS_CTL, 0, CTL_ZERO_BYTES, stream) != hipSuccess) return;
    Args a{};
    for (int i = 0; i < 27; ++i) a.in[i] = (const float*)d_in[i];
    a.out = (float*)d_out; a.ws = (unsigned char*)d_ws;
#if MK_SPLIT
    for (int p = 0; p < NPHASE; ++p) { a.ph_lo = p; a.ph_hi = p + 1; hipLaunchKernelGGL(fwd_kernel, dim3(grid), dim3(512), LDS_BYTES, stream, a); }
#else
    a.ph_lo = 0; a.ph_hi = NPHASE; hipLaunchKernelGGL(fwd_kernel, dim3(grid), dim3(512), LDS_BYTES, stream, a);
#endif
    const hipError_t le = hipPeekAtLastError();
    if (le != hipSuccess) fprintf(stderr, "kernel_launch: launch failed: %s\n", hipGetErrorName(le));
}
```
